# Optimizing an MI355X kernel written in HIP

```python
import math
import jax, jax.numpy as jnp
from jax import lax
import numpy as np


D_MODEL = 1024
BATCH = 2
SEQ = 16384
DEPTH = 4

N_A_LAYERS = DEPTH // 2
N_B_LAYERS = DEPTH - N_A_LAYERS
SSM_GROUP = 16
SSM_GROUPS = D_MODEL // SSM_GROUP
SSM_STATE = 64
SSM_CHUNK = 128
DT_MIN = 1e-3
DT_MAX = 1e-1
HEAD_DIM = 64
N_HEADS = D_MODEL // HEAD_DIM
N_KV_HEADS = N_HEADS // 4
GQA_GROUP = N_HEADS // N_KV_HEADS
WINDOW = 128
ATTN_BLOCK = 128
ROPE_THETA = 500000.0
ROT_DIM = HEAD_DIM // 4
D_FF = 4 * D_MODEL
PLE_DIM = 256
RMS_EPS = 1e-6
NEG_INF = -1e30

kernel_name = 'yoco_s5_swa_sink_hybrid'


def rmsnorm(x, g):
    xf = x.astype(jnp.float32)
    y = xf * lax.rsqrt(jnp.mean(xf * xf, axis=-1, keepdims=True) + RMS_EPS)
    return (y * g.astype(jnp.float32)).astype(x.dtype)


def partial_rope(x, pos):
    inv = ROPE_THETA ** (-jnp.arange(0, ROT_DIM, 2, dtype=jnp.float32) / ROT_DIM)
    ang = pos.astype(jnp.float32)[:, None] * inv[None, :]
    cos = jnp.cos(ang)[None, :, None, :]
    sin = jnp.sin(ang)[None, :, None, :]
    xr = x[..., :ROT_DIM].astype(jnp.float32)
    x1, x2 = xr[..., :ROT_DIM // 2], xr[..., ROT_DIM // 2:]
    rot = jnp.concatenate([x1 * cos - x2 * sin, x2 * cos + x1 * sin], axis=-1).astype(x.dtype)
    return jnp.concatenate([rot, x[..., ROT_DIM:]], axis=-1)


def s5_mixer(u, lam_re, lam_im, log_dt, b_re, b_im, c_re, c_im, d, w_glu):
    bsz, seqlen, dm = u.shape
    f32 = jnp.float32
    lam_re = lam_re.astype(f32); lam_im = lam_im.astype(f32)
    b_re = b_re.astype(f32); b_im = b_im.astype(f32)
    c_re = c_re.astype(f32); c_im = c_im.astype(f32)
    dt = jnp.exp(log_dt.astype(f32))[:, None]
    mag = jnp.exp(lam_re * dt)
    a_r = mag * jnp.cos(lam_im * dt)
    a_i = mag * jnp.sin(lam_im * dt)
    den = lam_re * lam_re + lam_im * lam_im
    nr = a_r - 1.0
    coef_r = (nr * lam_re + a_i * lam_im) / den
    coef_i = (a_i * lam_re - nr * lam_im) / den
    bb_r = coef_r[..., None] * b_re - coef_i[..., None] * b_im
    bb_i = coef_r[..., None] * b_im + coef_i[..., None] * b_re

    n_chunks = seqlen // SSM_CHUNK
    ug = u.astype(f32).reshape(bsz, n_chunks, SSM_CHUNK, SSM_GROUPS, SSM_GROUP)
    ug = jnp.transpose(ug, (1, 0, 2, 3, 4))

    def combine(e1, e2):
        a1r, a1i, s1r, s1i = e1
        a2r, a2i, s2r, s2i = e2
        return (a2r * a1r - a2i * a1i,
                a2r * a1i + a2i * a1r,
                a2r * s1r - a2i * s1i + s2r,
                a2r * s1i + a2i * s1r + s2i)

    def chunk_step(carry, uc):
        cr, ci = carry
        bur = jnp.einsum('gnh,btgh->btgn', bb_r, uc)
        bui = jnp.einsum('gnh,btgh->btgn', bb_i, uc)
        ar = jnp.broadcast_to(a_r, bur.shape)
        ai = jnp.broadcast_to(a_i, bui.shape)
        pr, pi, sr, si = lax.associative_scan(combine, (ar, ai, bur, bui), axis=1)
        xr = sr + pr * cr[:, None] - pi * ci[:, None]
        xi = si + pr * ci[:, None] + pi * cr[:, None]
        y = jnp.einsum('ghn,btgn->btgh', c_re, xr) - jnp.einsum('ghn,btgn->btgh', c_im, xi)
        return (xr[:, -1], xi[:, -1]), y

    init = (jnp.zeros((bsz, SSM_GROUPS, SSM_STATE), f32), jnp.zeros((bsz, SSM_GROUPS, SSM_STATE), f32))
    _, ys = lax.scan(chunk_step, init, ug)
    y = jnp.transpose(ys, (1, 0, 2, 3, 4)).reshape(bsz, seqlen, dm)
    y = y + d.astype(f32) * u.astype(f32)
    y = jax.nn.gelu(y).astype(u.dtype)
    ab = y @ w_glu
    a, b = ab[..., :dm], ab[..., dm:]
    return a * jax.nn.sigmoid(b)


def swa_sink_attention(q, k, v, sinks):
    bsz, seqlen = q.shape[0], q.shape[1]
    nb = seqlen // ATTN_BLOCK
    f32 = jnp.float32
    qb = q.astype(f32).reshape(bsz, nb, ATTN_BLOCK, N_KV_HEADS, GQA_GROUP, HEAD_DIM)
    kb = k.astype(f32).reshape(bsz, nb, ATTN_BLOCK, N_KV_HEADS, HEAD_DIM)
    vb = v.astype(f32).reshape(bsz, nb, ATTN_BLOCK, N_KV_HEADS, HEAD_DIM)
    k_prev = jnp.concatenate([jnp.zeros_like(kb[:, :1]), kb[:, :-1]], axis=1)
    v_prev = jnp.concatenate([jnp.zeros_like(vb[:, :1]), vb[:, :-1]], axis=1)
    kk = jnp.concatenate([k_prev, kb], axis=2)
    vv = jnp.concatenate([v_prev, vb], axis=2)
    s = jnp.einsum('bnqkgd,bnjkd->bnkgqj', qb, kk) * (HEAD_DIM ** -0.5)
    qi = jnp.arange(ATTN_BLOCK)[:, None] + ATTN_BLOCK
    kj = jnp.arange(2 * ATTN_BLOCK)[None, :]
    band = (kj <= qi) & (qi - kj < WINDOW)
    has_prev = jnp.arange(nb) > 0
    mask = band[None] & ((kj >= ATTN_BLOCK)[None] | has_prev[:, None, None])
    s = jnp.where(mask[None, :, None, None], s, NEG_INF)
    sink = sinks.astype(f32).reshape(1, 1, N_KV_HEADS, GQA_GROUP, 1, 1)
    m = jnp.maximum(jnp.max(s, axis=-1, keepdims=True), sink)
    pr = jnp.exp(s - m)
    w = pr / (jnp.sum(pr, axis=-1, keepdims=True) + jnp.exp(sink - m))
    o = jnp.einsum('bnkgqj,bnjkd->bnqkgd', w, vv)
    return o.reshape(bsz, seqlen, N_HEADS * HEAD_DIM).astype(q.dtype)


def setup_inputs(seed: int = 0) -> dict:
    key = jax.random.key(seed)
    ks = jax.random.split(key, 32)
    f32 = jnp.float32
    nrm = lambda k, shape, scale: jax.random.normal(k, shape, f32) * scale
    x = nrm(ks[0], (BATCH, SEQ, D_MODEL), 1.0)
    p = nrm(ks[1], (DEPTH, BATCH, SEQ, PLE_DIM), 1.0)
    norm_mix = 1.0 + nrm(ks[2], (DEPTH, D_MODEL), 0.02)
    ssm_lambda_re = -0.5 + nrm(ks[3], (N_A_LAYERS, SSM_GROUPS, SSM_STATE), 0.01)
    ssm_lambda_im = (jnp.pi * jnp.arange(SSM_STATE, dtype=f32))[None, None, :] + nrm(ks[4], (N_A_LAYERS, SSM_GROUPS, SSM_STATE), 0.01)
    ssm_log_dt = math.log(DT_MIN) + jax.random.uniform(ks[5], (N_A_LAYERS, SSM_GROUPS), f32) * (math.log(DT_MAX) - math.log(DT_MIN))
    ssm_b_re = nrm(ks[6], (N_A_LAYERS, SSM_GROUPS, SSM_STATE, SSM_GROUP), (2 * SSM_GROUP) ** -0.5)
    ssm_b_im = nrm(ks[7], (N_A_LAYERS, SSM_GROUPS, SSM_STATE, SSM_GROUP), (2 * SSM_GROUP) ** -0.5)
    ssm_c_re = nrm(ks[8], (N_A_LAYERS, SSM_GROUPS, SSM_GROUP, SSM_STATE), (2 * SSM_STATE) ** -0.5)
    ssm_c_im = nrm(ks[9], (N_A_LAYERS, SSM_GROUPS, SSM_GROUP, SSM_STATE), (2 * SSM_STATE) ** -0.5)
    ssm_d = nrm(ks[10], (N_A_LAYERS, D_MODEL), 1.0)
    ssm_w_glu = nrm(ks[11], (N_A_LAYERS, D_MODEL, 2 * D_MODEL), D_MODEL ** -0.5)
    kv_norm = 1.0 + nrm(ks[12], (D_MODEL,), 0.02)
    w_k = nrm(ks[13], (D_MODEL, N_KV_HEADS * HEAD_DIM), D_MODEL ** -0.5)
    w_v = nrm(ks[14], (D_MODEL, N_KV_HEADS * HEAD_DIM), D_MODEL ** -0.5)
    w_q = nrm(ks[15], (N_B_LAYERS, D_MODEL, N_HEADS * HEAD_DIM), D_MODEL ** -0.5)
    attn_sinks = nrm(ks[16], (N_B_LAYERS, N_HEADS), 0.5)
    w_o = nrm(ks[17], (N_B_LAYERS, N_HEADS * HEAD_DIM, D_MODEL), (N_HEADS * HEAD_DIM) ** -0.5)
    norm_mlp = 1.0 + nrm(ks[18], (DEPTH, D_MODEL), 0.02)
    w_up = nrm(ks[19], (DEPTH, D_MODEL, D_FF), D_MODEL ** -0.5)
    w_down = nrm(ks[20], (DEPTH, D_FF, D_MODEL), D_FF ** -0.5)
    norm_ple = 1.0 + nrm(ks[21], (DEPTH, D_MODEL), 0.02)
    w_ple_gate = nrm(ks[22], (DEPTH, D_MODEL, D_MODEL), D_MODEL ** -0.5)
    w_ple_proj = nrm(ks[23], (DEPTH, PLE_DIM, D_MODEL), PLE_DIM ** -0.5)
    norm_final = 1.0 + nrm(ks[24], (D_MODEL,), 0.02)
    return {'x': x, 'p': p, 'norm_mix': norm_mix,
            'ssm_lambda_re': ssm_lambda_re, 'ssm_lambda_im': ssm_lambda_im, 'ssm_log_dt': ssm_log_dt,
            'ssm_b_re': ssm_b_re, 'ssm_b_im': ssm_b_im, 'ssm_c_re': ssm_c_re, 'ssm_c_im': ssm_c_im,
            'ssm_d': ssm_d, 'ssm_w_glu': ssm_w_glu,
            'kv_norm': kv_norm, 'w_k': w_k, 'w_v': w_v, 'w_q': w_q, 'attn_sinks': attn_sinks, 'w_o': w_o,
            'norm_mlp': norm_mlp, 'w_up': w_up, 'w_down': w_down,
            'norm_ple': norm_ple, 'w_ple_gate': w_ple_gate, 'w_ple_proj': w_ple_proj,
            'norm_final': norm_final}


def reference(x, p, norm_mix, ssm_lambda_re, ssm_lambda_im, ssm_log_dt, ssm_b_re, ssm_b_im,
              ssm_c_re, ssm_c_im, ssm_d, ssm_w_glu, kv_norm, w_k, w_v, w_q, attn_sinks, w_o,
              norm_mlp, w_up, w_down, norm_ple, w_ple_gate, w_ple_proj, norm_final):
    bsz, seqlen, _ = x.shape
    pos = jnp.arange(seqlen, dtype=jnp.int32)
    h = x
    k_shared = None
    v_shared = None
    for i in range(DEPTH):
        hn = rmsnorm(h, norm_mix[i])
        if i < N_A_LAYERS:
            mix = s5_mixer(hn, ssm_lambda_re[i], ssm_lambda_im[i], ssm_log_dt[i], ssm_b_re[i], ssm_b_im[i],
                           ssm_c_re[i], ssm_c_im[i], ssm_d[i], ssm_w_glu[i])
        else:
            j = i - N_A_LAYERS
            q = (hn @ w_q[j]).reshape(bsz, seqlen, N_HEADS, HEAD_DIM)
            q = partial_rope(q, pos)
            mix = swa_sink_attention(q, k_shared, v_shared, attn_sinks[j]) @ w_o[j]
        h = h + mix
        hm = rmsnorm(h, norm_mlp[i])
        h = h + jnp.square(jax.nn.relu(hm @ w_up[i])) @ w_down[i]
        gate = jax.nn.sigmoid(rmsnorm(h, norm_ple[i]) @ w_ple_gate[i])
        h = h + gate * (p[i] @ w_ple_proj[i])
        if i == N_A_LAYERS - 1:
            hk = rmsnorm(h, kv_norm)
            k_shared = partial_rope((hk @ w_k).reshape(bsz, seqlen, N_KV_HEADS, HEAD_DIM), pos)
            v_shared = (hk @ w_v).reshape(bsz, seqlen, N_KV_HEADS, HEAD_DIM)
    return rmsnorm(h, norm_final)
```

```cpp
#include <hip/hip_runtime.h>
#include <hip/hip_cooperative_groups.h>
#include <cstdio>
#include <cstdint>
#include <cmath>
namespace cg = cooperative_groups;
#ifndef MK_SINGLE
#define MK_SINGLE 1
#endif
namespace pg8 {
#define PG8_LAS __attribute__((address_space(3)))
typedef unsigned short bf16_t;
typedef short bf16x8 __attribute__((ext_vector_type(8)));
typedef float f32x4 __attribute__((ext_vector_type(4)));
typedef unsigned u32x4 __attribute__((ext_vector_type(4)));
constexpr int BM = 256, BK = 64, HALF = 128, HTB = HALF * BK * 2  , STAGE_BYTES = 8 * HTB, NXCD = 8, WGM = 8;

__host__ __device__ __forceinline__ int lds_byte(int r, int c) { const int st = (r >> 4) * 2 + (c >> 5), rr = r & 15, cc = c & 31, ob = rr * 64 + cc * 2; return st * 1024 + (ob ^ (((ob >> 9) & 1) << 5)); }
__host__ __device__ __forceinline__ void stage_rc(int b, int& R, int& C) { const int st = b / 1024, sb = b % 1024, swz = sb ^ (((sb >> 9) & 1) << 5); R = (st >> 1) * 16 + swz / 64; C = (st & 1) * 32 + (swz % 64) / 2; }
__host__ __device__ __forceinline__ int perm32(int rho) { const int n = rho >> 4, i = rho & 15; return 8 * (i >> 2) + 4 * n + (i & 3); }

struct Unit { int pm, pn; };
struct Gemm { const bf16_t* A; const bf16_t* Bt; int M, N, K; };

struct StaticOrder {
    int nM, nN, nwg, G, c;
    __host__ __device__ void init(int M, int N, int G_, int c_) { nM = M / BM; nN = N / BM; nwg = nM * nN; G = G_; c = c_; }
    __host__ __device__ bool next(int i, Unit& u) const {
        const long L = (long)i * G + c; if (L >= nwg) return false;
        int wgid = (int)L; { const int q = nwg / NXCD, r = nwg % NXCD, xcd = wgid % NXCD, off = wgid / NXCD; wgid = (xcd < r ? xcd * (q + 1) : r * (q + 1) + (xcd - r) * q) + off; }
        const int nig = WGM * nN, gid = wgid / nig, fm = gid * WGM, gsz = (nM - fm) < WGM ? (nM - fm) : WGM;
        u.pm = fm + ((wgid % nig) % gsz); u.pn = (wgid % nig) / gsz; return true;
    }
    __device__ __forceinline__ void a_ready(const Unit&) const {}
    __device__ __forceinline__ void done(const Unit&) const {}
};

typedef float f32x2_cv __attribute__((ext_vector_type(2))); typedef __bf16 bf16x2_cv __attribute__((ext_vector_type(2)));
__device__ __forceinline__ unsigned cvt_pk_bf16(float lo, float hi) { const f32x2_cv v = {lo, hi}; const bf16x2_cv b = __builtin_convertvector(v, bf16x2_cv); return __builtin_bit_cast(unsigned, b); }
typedef float f32x2 __attribute__((ext_vector_type(2)));
typedef unsigned u32x2 __attribute__((ext_vector_type(2)));
constexpr float RMS_EPS = 1e-6f, LOG2E = 1.4426950408889634f;
template <int NQ> __device__ __forceinline__ float rstd_of(const float* ss, int row) { const f32x4* p = (const f32x4*)(ss + (size_t)row * 32); float t = 0.f;
#pragma unroll
    for (int i = 0; i < NQ; ++i) { const f32x4 v = p[i]; t += (v[0] + v[1]) + (v[2] + v[3]); }
    return __builtin_amdgcn_rsqf(t * (1.0f / 1024.0f) + RMS_EPS); }
template <int NQ> __device__ __forceinline__ float rstd_epi(const float* ss, int row, int fq) { const f32x4* p = (const f32x4*)(ss + (size_t)row * 32) + fq; f32x4 v = p[0]; float t = (v[0] + v[1]) + (v[2] + v[3]);
    if (NQ == 8) { v = p[4]; t += (v[0] + v[1]) + (v[2] + v[3]); }
    t += __shfl_xor(t, 16); t += __shfl_xor(t, 32);
    return __builtin_amdgcn_rsqf(t * (1.0f / 1024.0f) + RMS_EPS); }
__device__ __forceinline__ float bflo(unsigned w) { return __builtin_bit_cast(float, w << 16); }
__device__ __forceinline__ float bfhi(unsigned w) { return __builtin_bit_cast(float, w & 0xffff0000u); }
__device__ __forceinline__ void unpack8(u32x4 w, f32x4& a, f32x4& b) { a[0] = bflo(w.x); a[1] = bfhi(w.x); a[2] = bflo(w.y); a[3] = bfhi(w.y); b[0] = bflo(w.z); b[1] = bfhi(w.z); b[2] = bflo(w.w); b[3] = bfhi(w.w); }
__device__ __forceinline__ float sumsq_pk(unsigned w) { const float a = bflo(w), b = bfhi(w); return a * a + b * b; }
__device__ __forceinline__ float sigmoidf_(float v) { return __builtin_amdgcn_rcpf(1.0f + __builtin_amdgcn_exp2f(-LOG2E * v)); }
__device__ __forceinline__ float sumsq4(f32x4 v) { return (v[0] * v[0] + v[1] * v[1]) + (v[2] * v[2] + v[3] * v[3]); }
__device__ __forceinline__ u32x4 pack8(f32x4 v0, f32x4 v1) { u32x4 w; w.x = cvt_pk_bf16(v0[0], v0[1]); w.y = cvt_pk_bf16(v0[2], v0[3]); w.z = cvt_pk_bf16(v1[0], v1[1]); w.w = cvt_pk_bf16(v1[2], v1[3]); return w; }

template <int NQ> __device__ __forceinline__ void slots_issue(const float* ss, int row, int fq, f32x4 (&v)[2]) { const f32x4* p = (const f32x4*)(ss + (size_t)row * 32) + fq; v[0] = p[0]; if (NQ == 8) v[1] = p[4]; }
template <int NQ> __device__ __forceinline__ float slots_rstd(const f32x4 (&v)[2]) { float t = (v[0][0] + v[0][1]) + (v[0][2] + v[0][3]); if (NQ == 8) t += (v[1][0] + v[1][1]) + (v[1][2] + v[1][3]);
    t += __shfl_xor(t, 16); t += __shfl_xor(t, 32); return __builtin_amdgcn_rsqf(t * (1.0f / 1024.0f) + RMS_EPS); }

struct EpiUp {
    static constexpr bool PERM = true, AFTER_DRAIN = false;
    bf16_t* O;
    __device__ __forceinline__ void operator()(const f32x4 (&acc)[2][2][4][2], const Unit& u, int wr, int wc, int fr, int fq) const {
        const int row0 = u.pm * BM + wr * 64 + fr, col0 = u.pn * BM + wc * 32 + 8 * fq;
#pragma unroll
        for (int ai = 0; ai < 2; ++ai)
#pragma unroll
            for (int m = 0; m < 4; ++m) { const int row = row0 + ai * HALF + m * 16;
                bf16_t* rowp = O + ((size_t)(row >> 8) * 64 + (col0 >> 6)) * 16384 + (size_t)(row & 255) * 64 + (col0 & 63);
#pragma unroll
                for (int bj = 0; bj < 2; ++bj) { f32x4 v0 = acc[ai][bj][m][0], v1 = acc[ai][bj][m][1];
#pragma unroll
                    for (int e = 0; e < 4; ++e) { const float a0 = fmaxf(v0[e], 0.f), a1 = fmaxf(v1[e], 0.f); v0[e] = a0 * a0; v1[e] = a1 * a1; }
                    *(u32x4*)(rowp + bj * 2 * 16384) = pack8(v0, v1); } }
    }
};
template <int NQ> struct EpiRes {
    static constexpr bool PERM = true, AFTER_DRAIN = false;
    const bf16_t* base; bf16_t* hb; float* ssout; const float* ss;
    __device__ __forceinline__ void operator()(const f32x4 (&acc)[2][2][4][2], const Unit& u, int wr, int wc, int fr, int fq) const {
        const int row0 = u.pm * BM + wr * 64 + fr, col0 = u.pn * BM + wc * 32 + 8 * fq;
#pragma unroll
        for (int ai = 0; ai < 2; ++ai) {
            u32x4 bw[4][2]; f32x4 sv[4][2];
#pragma unroll
            for (int m = 0; m < 4; ++m) { if (NQ > 0) slots_issue<NQ == 8 ? 8 : 4>(ss, row0 + ai * HALF + m * 16, fq, sv[m]);
#pragma unroll
                for (int bj = 0; bj < 2; ++bj) bw[m][bj] = *(const u32x4*)(base + (size_t)(row0 + ai * HALF + m * 16) * 1024 + col0 + bj * HALF); }
#pragma unroll
            for (int m = 0; m < 4; ++m) { const int row = row0 + ai * HALF + m * 16; const size_t off = (size_t)row * 1024 + col0; float s = 0.f;
                float sc = 1.f; if (NQ > 0) { const float r = slots_rstd<NQ == 8 ? 8 : 4>(sv[m]); sc = r * r; }
#pragma unroll
                for (int bj = 0; bj < 2; ++bj) { f32x4 b0, b1; unpack8(bw[m][bj], b0, b1);
                    const u32x4 w = pack8(b0 + acc[ai][bj][m][0] * sc, b1 + acc[ai][bj][m][1] * sc);
                    *(u32x4*)(hb + off + bj * HALF) = w; s += (sumsq_pk(w.x) + sumsq_pk(w.y)) + (sumsq_pk(w.z) + sumsq_pk(w.w)); }
                s += __shfl_xor(s, 16); s += __shfl_xor(s, 32);
                if (fq == 0) ssout[(size_t)row * 32 + 4 * u.pn + wc] = s; }
            asm volatile("" ::: "memory"); }
    }
};
struct EpiGlu {
    static constexpr bool PERM = true, AFTER_DRAIN = false;
    const bf16_t* base; bf16_t* hb; float* ssout;
    __device__ __forceinline__ void operator()(const f32x4 (&acc)[2][2][4][2], const Unit& u, int wr, int wc, int fr, int fq) const {
        const int row0 = u.pm * BM + wr * 64 + fr, ch0 = u.pn * 128 + wc * 16 + 4 * fq;
#pragma unroll
        for (int ai = 0; ai < 2; ++ai) {
            u32x2 bw[4][2];
#pragma unroll
            for (int m = 0; m < 4; ++m)
#pragma unroll
                for (int bj = 0; bj < 2; ++bj) bw[m][bj] = *(const u32x2*)(base + (size_t)(row0 + ai * HALF + m * 16) * 1024 + ch0 + bj * 64);
#pragma unroll
            for (int m = 0; m < 4; ++m) { const int row = row0 + ai * HALF + m * 16; const size_t off = (size_t)row * 1024 + ch0; float s = 0.f;
#pragma unroll
                for (int bj = 0; bj < 2; ++bj) { const f32x4 av = acc[ai][bj][m][0], bv = acc[ai][bj][m][1];
                    const float h0 = bflo(bw[m][bj].x) + av[0] * sigmoidf_(bv[0]), h1 = bfhi(bw[m][bj].x) + av[1] * sigmoidf_(bv[1]), h2 = bflo(bw[m][bj].y) + av[2] * sigmoidf_(bv[2]), h3 = bfhi(bw[m][bj].y) + av[3] * sigmoidf_(bv[3]);
                    u32x2 w; w.x = cvt_pk_bf16(h0, h1); w.y = cvt_pk_bf16(h2, h3); *(u32x2*)(hb + off + bj * 64) = w; s += sumsq_pk(w.x) + sumsq_pk(w.y); }
                s += __shfl_xor(s, 16); s += __shfl_xor(s, 32);
                if (fq == 0) ssout[(size_t)row * 32 + 4 * u.pn + wc] = s; }
            asm volatile("" ::: "memory"); }
    }
};
struct EpiPP {
    static constexpr bool PERM = true, AFTER_DRAIN = false;
    bf16_t* pp;
    __device__ __forceinline__ void operator()(const f32x4 (&acc)[2][2][4][2], const Unit& u, int wr, int wc, int fr, int fq) const {
        const int row0 = u.pm * BM + wr * 64 + fr, col0 = u.pn * BM + wc * 32 + 8 * fq;
#pragma unroll
        for (int ai = 0; ai < 2; ++ai)
#pragma unroll
            for (int m = 0; m < 4; ++m) { const size_t off = (size_t)(row0 + ai * HALF + m * 16) * 1024 + col0;
#pragma unroll
                for (int bj = 0; bj < 2; ++bj) *(u32x4*)(pp + off + bj * HALF) = pack8(acc[ai][bj][m][0], acc[ai][bj][m][1]);
                asm volatile("" ::: "memory"); }
    }
};
struct EpiGate {
    static constexpr bool PERM = true, AFTER_DRAIN = false;
    const bf16_t* base; bf16_t* hb; float* ssout; const float* ss; const bf16_t* pp;
    __device__ __forceinline__ void operator()(const f32x4 (&acc)[2][2][4][2], const Unit& u, int wr, int wc, int fr, int fq) const {
        const int row0 = u.pm * BM + wr * 64 + fr, col0 = u.pn * BM + wc * 32 + 8 * fq;
#pragma unroll
        for (int ai = 0; ai < 2; ++ai)
#pragma unroll
            for (int mh = 0; mh < 2; ++mh) {
                u32x4 bw[2][2], pw[2][2]; f32x4 sv[2][2];
#pragma unroll
                for (int mm = 0; mm < 2; ++mm) { const int row = row0 + ai * HALF + (2 * mh + mm) * 16; slots_issue<4>(ss, row, fq, sv[mm]);
#pragma unroll
                    for (int bj = 0; bj < 2; ++bj) { bw[mm][bj] = *(const u32x4*)(base + (size_t)row * 1024 + col0 + bj * HALF); pw[mm][bj] = *(const u32x4*)(pp + (size_t)row * 1024 + col0 + bj * HALF); } }
#pragma unroll
                for (int mm = 0; mm < 2; ++mm) { const int m = 2 * mh + mm, row = row0 + ai * HALF + m * 16; const size_t off = (size_t)row * 1024 + col0; float s = 0.f; const float rs = slots_rstd<4>(sv[mm]);
#pragma unroll
                    for (int bj = 0; bj < 2; ++bj) { f32x4 b0, b1, p0, p1; unpack8(bw[mm][bj], b0, b1); unpack8(pw[mm][bj], p0, p1);
#pragma unroll
                        for (int e = 0; e < 4; ++e) { b0[e] += sigmoidf_(acc[ai][bj][m][0][e] * rs) * p0[e]; b1[e] += sigmoidf_(acc[ai][bj][m][1][e] * rs) * p1[e]; }
                        const u32x4 w = pack8(b0, b1);
                        *(u32x4*)(hb + off + bj * HALF) = w; s += (sumsq_pk(w.x) + sumsq_pk(w.y)) + (sumsq_pk(w.z) + sumsq_pk(w.w)); }
                    s += __shfl_xor(s, 16); s += __shfl_xor(s, 32);
                    if (fq == 0) ssout[(size_t)row * 32 + 4 * u.pn + wc] = s; }
                asm volatile("" ::: "memory"); }
    }
};
struct EpiQKV {
    static constexpr bool PERM = true, AFTER_DRAIN = false;
    bf16_t* Qo; bf16_t* Ko; bf16_t* Vto; const float* ss; const float* ropeC; const float* ropeS;
    __device__ __forceinline__ void operator()(const f32x4 (&acc)[2][2][4][2], const Unit& u, int wr, int wc, int fr, int fq) const {
        const int row0 = u.pm * BM + wr * 64 + fr, cl0 = wc * 32 + 8 * fq;
        const int kind = u.pn < 4 ? 0 : (u.pn == 4 ? 1 : 2);
        const bool rot_wave = ((wc & 1) == 0) && kind != 2; const bool rot_lane = rot_wave && fq < 2; const float sgn = fq == 0 ? -1.f : 1.f;
#pragma unroll
        for (int ai = 0; ai < 2; ++ai) {
            f32x4 sv[4][2];
#pragma unroll
            for (int m = 0; m < 4; ++m) slots_issue<4>(ss, row0 + ai * HALF + m * 16, fq, sv[m]);
#pragma unroll
            for (int m = 0; m < 4; ++m) { const int row = row0 + ai * HALF + m * 16; const float rs = slots_rstd<4>(sv[m]); const int pos = row & 16383;
                f32x4 c0 = {1.f, 1.f, 1.f, 1.f}, c1 = c0, s0 = {0.f, 0.f, 0.f, 0.f}, s1 = s0;
                if (rot_lane) { c0 = *(const f32x4*)(ropeC + pos * 8); c1 = *(const f32x4*)(ropeC + pos * 8 + 4); s0 = *(const f32x4*)(ropeS + pos * 8) * sgn; s1 = *(const f32x4*)(ropeS + pos * 8 + 4) * sgn; }
#pragma unroll
                for (int bj = 0; bj < 2; ++bj) { f32x4 v0 = acc[ai][bj][m][0] * rs, v1 = acc[ai][bj][m][1] * rs;
                    if (rot_wave) { f32x4 q0, q1;
#pragma unroll
                        for (int e = 0; e < 4; ++e) { q0[e] = __shfl_xor(v0[e], 16); q1[e] = __shfl_xor(v1[e], 16); }
                        v0 = v0 * c0 + q0 * s0; v1 = v1 * c1 + q1 * s1; }
                    const int col = u.pn * BM + bj * HALF + cl0;
                    if (kind == 0) *(u32x4*)(Qo + (size_t)row * 1024 + col) = pack8(v0, v1);
                    else if (kind == 1) *(u32x4*)(Ko + (size_t)row * 256 + (col - 1024)) = pack8(v0, v1);
                    else { const int cv = col - 1280, kh = cv >> 6, d0 = cv & 63, b = row >> 14; bf16_t* vp = Vto + ((size_t)((b * 4 + kh) * 64 + d0) * 16384 + pos); const u32x4 w = pack8(v0, v1);
                        vp[0] = (bf16_t)(w.x & 0xffff); vp[16384] = (bf16_t)(w.x >> 16); vp[2 * 16384] = (bf16_t)(w.y & 0xffff); vp[3 * 16384] = (bf16_t)(w.y >> 16);
                        vp[4 * 16384] = (bf16_t)(w.z & 0xffff); vp[5 * 16384] = (bf16_t)(w.z >> 16); vp[6 * 16384] = (bf16_t)(w.w & 0xffff); vp[7 * 16384] = (bf16_t)(w.w >> 16); } } asm volatile("" ::: "memory"); } }
    }
};
template <class Epi, class Sched, bool ALIGN_EPI = false, bool SP2 = false, bool A_BLK = false  >
__device__ __forceinline__ void gemm_phase(PG8_LAS unsigned char* lds, const Gemm g, const Sched& S, const Epi& E) {
    int tid_ = threadIdx.x; asm volatile("" : "+v"(tid_));
    const int tid = tid_, wid = __builtin_amdgcn_readfirstlane(tid >> 6), lane = tid & 63, wr = wid >> 2, wc = wid & 3, fr = lane & 15, fq = lane >> 4;
    int Kq = g.K; asm volatile("" : "+s"(Kq)); const int K = Kq, nt = K / BK;
    unsigned voffA[2], voffB[2];
#pragma unroll
    for (int i = 0; i < 2; ++i) { int R, C; stage_rc(tid * 16 + i * 8192, R, C); const int Rb = Epi::PERM ? ((R & ~31) + perm32(R & 31)) : R;
        voffA[i] = A_BLK ? (unsigned)(R * 64 + C) * 2u : (unsigned)(R * K + C) * 2u; voffB[i] = (unsigned)(Rb * 64 + C) * 2u;     }
    const size_t kstep = (size_t)(BK * 2);
    const size_t hstep = (size_t)HALF * K * 2;
    const size_t tstep = 2 * hstep;
    const size_t kstepB = 32768, hstepB = 16384, tstepB = (size_t)(K / 64) * 32768;
    const size_t kstepA = A_BLK ? (size_t)32768 : kstep, hstepA = A_BLK ? (size_t)16384 : hstep, tstepA = A_BLK ? (size_t)(K / 64) * 32768 : tstep;
    const unsigned ldsw = (unsigned)wid * 1024u;
    const int aoff = lds_byte(wr * 64 + fr, fq * 8), boff = lds_byte(wc * 32 + fr, fq * 8);
#define PG8_SA(b, h) (((b) * 2 + (h)) * HTB)
#define PG8_SB(b, h) ((4 + (b) * 2 + (h)) * HTB)
#define PG8_STAGE(bufoff, gbase, voff) do { _Pragma("unroll") for (int _i = 0; _i < 2; ++_i) \
        __builtin_amdgcn_global_load_lds((const unsigned*)((const char*)(gbase) + (voff)[_i]), (PG8_LAS unsigned*)(lds + (bufoff) + ldsw + _i * 8192), 16, 0, 0); } while (0)
#define PG8_LDA(dst, b, h) do { _Pragma("unroll") for (int m = 0; m < 4; ++m) _Pragma("unroll") for (int k = 0; k < 2; ++k) dst[m][k] = *(const PG8_LAS bf16x8*)(lds + PG8_SA(b, h) + aoff + m * 2048 + k * 1024); } while (0)
#define PG8_LDB(dst, b, h) do { _Pragma("unroll") for (int n = 0; n < 2; ++n) _Pragma("unroll") for (int k = 0; k < 2; ++k) dst[n][k] = *(const PG8_LAS bf16x8*)(lds + PG8_SB(b, h) + boff + n * 2048 + k * 1024); } while (0)
#define PG8_MMA(ai, bj, At, Bt) do { __builtin_amdgcn_s_setprio(1); _Pragma("unroll") for (int m = 0; m < 4; ++m) _Pragma("unroll") for (int n = 0; n < 2; ++n) _Pragma("unroll") for (int k = 0; k < 2; ++k) \
        acc[ai][bj][m][n] = __builtin_amdgcn_mfma_f32_16x16x32_bf16(Bt[n][k], At[m][k], acc[ai][bj][m][n], 0, 0, 0); __builtin_amdgcn_s_setprio(0); } while (0)
#define PG8_WAIT_V(n) asm volatile("s_waitcnt vmcnt(" #n ")" ::: "memory")
#define PG8_WAIT_L(n) asm volatile("s_waitcnt lgkmcnt(" #n ")" ::: "memory")
#define PG8_BAR __builtin_amdgcn_s_barrier()
#define PG8_SCHED __builtin_amdgcn_sched_barrier(0)
    Unit cur, nxt; int ui = 0;
    if (!S.next(0, cur)) return;
    f32x4 acc[2][2][4][2];
#pragma unroll
    for (int a = 0; a < 2; ++a)
#pragma unroll
        for (int b = 0; b < 2; ++b)
#pragma unroll
            for (int m = 0; m < 4; ++m)
#pragma unroll
                for (int n = 0; n < 2; ++n) acc[a][b][m][n] = (f32x4){0.f, 0.f, 0.f, 0.f};
    bf16x8 At[4][2], B0[2][2], B1[2][2];
    const char* cA = (const char*)g.A + (size_t)cur.pm * tstepA; const char* cB = (const char*)g.Bt + (size_t)cur.pn * tstepB;
    S.a_ready(cur);
    if constexpr (SP2) {
        PG8_STAGE(PG8_SB(0, 0), cB, voffB); PG8_STAGE(PG8_SB(0, 1), cB + hstepB, voffB); PG8_STAGE(PG8_SA(0, 0), cA, voffA); PG8_STAGE(PG8_SA(0, 1), cA + hstepA, voffA);
        if (wr == 1) PG8_BAR;
        PG8_WAIT_V(2); PG8_BAR;
        PG8_STAGE(PG8_SB(1, 0), cB + kstepB, voffB); PG8_STAGE(PG8_SA(1, 0), cA + kstepA, voffA); PG8_STAGE(PG8_SB(1, 1), cB + hstepB + kstepB, voffB);
        PG8_WAIT_V(6); PG8_BAR;
    } else {
        PG8_STAGE(PG8_SB(0, 0), cB, voffB); PG8_STAGE(PG8_SA(0, 0), cA, voffA); PG8_STAGE(PG8_SB(0, 1), cB + hstepB, voffB); PG8_STAGE(PG8_SA(0, 1), cA + hstepA, voffA);
        if (wr == 1) PG8_BAR;
        PG8_WAIT_V(4); PG8_BAR;
        PG8_STAGE(PG8_SB(1, 0), cB + kstepB, voffB); PG8_STAGE(PG8_SA(1, 0), cA + kstepA, voffA); PG8_STAGE(PG8_SB(1, 1), cB + hstepB + kstepB, voffB);
        PG8_WAIT_V(6); PG8_BAR;
    }
    for (;;) {
        const bool has_next = S.next(ui + 1, nxt);
        const char* nA = has_next ? (const char*)g.A + (size_t)nxt.pm * tstepA : cA; const char* nB = has_next ? (const char*)g.Bt + (size_t)nxt.pn * tstepB : cB;
        for (int t = 0; t < nt; t += 2) {
            const bool last = (t == nt - 2);
            const char* a1 = cA + (size_t)(t + 1) * kstepA;
            const char* a2 = last ? nA : cA + (size_t)(t + 2) * kstepA; const char* b2 = last ? nB : cB + (size_t)(t + 2) * kstepB;
            const char* a3 = a2 + kstepA; const char* b3 = b2 + kstepB;
            if (last && has_next) S.a_ready(nxt);
            if constexpr (SP2) {
            PG8_LDB(B0, 0, 0); PG8_LDB(B1, 0, 1); PG8_SCHED; PG8_LDA(At, 0, 0); PG8_STAGE(PG8_SA(1, 1), a1 + hstepA, voffA);
            PG8_WAIT_V(8); PG8_WAIT_L(0); PG8_BAR; PG8_MMA(0, 0, At, B0); PG8_MMA(0, 1, At, B1); PG8_BAR; PG8_SCHED;
            PG8_LDA(At, 0, 1); PG8_STAGE(PG8_SB(0, 0), b2, voffB); PG8_STAGE(PG8_SB(0, 1), b2 + hstepB, voffB); PG8_STAGE(PG8_SA(0, 0), a2, voffA);
            PG8_WAIT_V(8); PG8_WAIT_L(0); PG8_BAR; PG8_MMA(1, 0, At, B0); PG8_MMA(1, 1, At, B1); PG8_BAR; PG8_SCHED;
            PG8_LDB(B0, 1, 0); PG8_LDB(B1, 1, 1); PG8_SCHED; PG8_LDA(At, 1, 0); PG8_STAGE(PG8_SA(0, 1), a2 + hstepA, voffA);
            PG8_WAIT_V(8); PG8_WAIT_L(0); PG8_BAR; PG8_MMA(0, 0, At, B0); PG8_MMA(0, 1, At, B1); PG8_BAR; PG8_SCHED;
            PG8_LDA(At, 1, 1); PG8_STAGE(PG8_SB(1, 0), b3, voffB); PG8_STAGE(PG8_SB(1, 1), b3 + hstepB, voffB); PG8_STAGE(PG8_SA(1, 0), a3, voffA);
            PG8_WAIT_V(8); PG8_WAIT_L(0); PG8_BAR; PG8_MMA(1, 0, At, B0); PG8_MMA(1, 1, At, B1); PG8_BAR; PG8_SCHED;
            } else {
            PG8_LDB(B0, 0, 0); PG8_SCHED; PG8_LDA(At, 0, 0); PG8_STAGE(PG8_SA(1, 1), a1 + hstepA, voffA);
            PG8_WAIT_L(8); PG8_BAR; PG8_WAIT_L(0); PG8_MMA(0, 0, At, B0); PG8_BAR; PG8_SCHED;
            PG8_LDB(B1, 0, 1); PG8_STAGE(PG8_SB(0, 0), b2, voffB);
            PG8_BAR; PG8_WAIT_L(0); PG8_MMA(0, 1, At, B1); PG8_BAR;
            PG8_LDA(At, 0, 1); PG8_STAGE(PG8_SA(0, 0), a2, voffA);
            PG8_BAR; PG8_WAIT_L(0); PG8_MMA(1, 0, At, B0); PG8_BAR; PG8_SCHED;
            PG8_STAGE(PG8_SB(0, 1), b2 + hstepB, voffB);
            PG8_WAIT_V(6); PG8_BAR; PG8_MMA(1, 1, At, B1); PG8_BAR;
            PG8_LDB(B0, 1, 0); PG8_SCHED; PG8_LDA(At, 1, 0); PG8_STAGE(PG8_SA(0, 1), a2 + hstepA, voffA);
            PG8_WAIT_L(8); PG8_BAR; PG8_WAIT_L(0); PG8_MMA(0, 0, At, B0); PG8_BAR; PG8_SCHED;
            PG8_LDB(B1, 1, 1); PG8_STAGE(PG8_SB(1, 0), b3, voffB);
            PG8_BAR; PG8_WAIT_L(0); PG8_MMA(0, 1, At, B1); PG8_BAR;
            PG8_LDA(At, 1, 1); PG8_STAGE(PG8_SA(1, 0), a3, voffA);
            PG8_BAR; PG8_WAIT_L(0); PG8_MMA(1, 0, At, B0); PG8_BAR; PG8_SCHED;
            PG8_STAGE(PG8_SB(1, 1), b3 + hstepB, voffB);
            PG8_WAIT_V(6); PG8_BAR; PG8_MMA(1, 1, At, B1); PG8_BAR;
            }
        }
        if constexpr (ALIGN_EPI) { if (wr == 0) PG8_BAR; }
        if constexpr (!Epi::AFTER_DRAIN) { E(acc, cur, wr, wc, fr, fq); S.done(cur); }
        if (!has_next) break;
#pragma unroll
        for (int a = 0; a < 2; ++a)
#pragma unroll
            for (int b = 0; b < 2; ++b)
#pragma unroll
                for (int m = 0; m < 4; ++m)
#pragma unroll
                    for (int n = 0; n < 2; ++n) acc[a][b][m][n] = (f32x4){0.f, 0.f, 0.f, 0.f};
        cur = nxt; cA = nA; cB = nB; ++ui;
        if constexpr (ALIGN_EPI) { if (wr == 1) PG8_BAR; }
    }
    PG8_WAIT_V(0);
    if constexpr (!ALIGN_EPI) { if (wr == 0) PG8_BAR; }
    PG8_BAR;
    if constexpr (Epi::AFTER_DRAIN) { E.fused(acc, cur, wr, wc, fr, fq, lds, wid, lane); S.done(cur); }
#undef PG8_SA
#undef PG8_SB
#undef PG8_STAGE
#undef PG8_LDA
#undef PG8_LDB
#undef PG8_MMA
#undef PG8_WAIT_V
#undef PG8_WAIT_L
#undef PG8_BAR
#undef PG8_SCHED
}
}
#define LAS __attribute__((address_space(3)))
typedef unsigned short bf16;
typedef unsigned v4u __attribute__((ext_vector_type(4)));
typedef unsigned v2u __attribute__((ext_vector_type(2)));
typedef float f32x4 __attribute__((ext_vector_type(4)));
typedef float f32x2 __attribute__((ext_vector_type(2)));
typedef float f32x16 __attribute__((ext_vector_type(16)));
typedef short bf16x8 __attribute__((ext_vector_type(8)));
constexpr int SEQ = 16384, NB = 2, MT = NB * SEQ, DM = 1024, FF = 4096, PLE = 256;
constexpr size_t MiB = 1u << 20;
constexpr size_t WS_CTL = 0;
constexpr size_t WS_SS = 465 * MiB;
constexpr size_t WS_ROPE = 3 * MiB;
constexpr size_t WS_S5T = 4 * MiB;
constexpr size_t WS_WGLU = 6 * MiB, WS_WUP = 14 * MiB, WS_WDOWN = 46 * MiB, WS_WGATE = 78 * MiB, WS_WPROJ = 86 * MiB, WS_WQKV2 = 88 * MiB, WS_WQ3 = 91 * MiB, WS_WO = 93 * MiB;
constexpr size_t WS_PB = 97 * MiB, WS_K = 113 * MiB, WS_VT = 129 * MiB, WS_HB = 145 * MiB, WS_ACT = 209 * MiB, WS_END = 481 * MiB;
constexpr size_t ACT_Y = 0, ACT_Q = 0, ACT_O = 64 * MiB, ACT_PP = 0, ACT_HB2 = 128 * MiB, ACT_ST = 192 * MiB;
constexpr int LDS_BYTES = 147456, NPHASE = 28;
constexpr float C2 = 0.125f * 1.4426950408889634f;

__device__ __forceinline__ int tid_opq() { int t = threadIdx.x; asm volatile("" : "+v"(t)); return t; }
__device__ __forceinline__ int bid_opq() { int t = blockIdx.x; asm volatile("" : "+s"(t)); return t; }
#define LDS_WAIT() asm volatile("s_waitcnt lgkmcnt(0)" ::: "memory")
__device__ __forceinline__ unsigned f2bf(float f) { unsigned u = __builtin_bit_cast(unsigned, f); return (u + 0x7fffu + ((u >> 16) & 1u)) >> 16; }
__device__ __forceinline__ unsigned pk2(float lo, float hi) { return f2bf(lo) | (f2bf(hi) << 16); }
__device__ __forceinline__ float wave_sum(float v) {
#pragma unroll
    for (int o = 1; o < 64; o <<= 1) v += __shfl_xor(v, o);
    return v;
}
__device__ __forceinline__ void sincos_d(double x, float& s, float& c) {
    const double k = __builtin_rint(x * 0.63661977236758134308);
    double r = __builtin_fma(-k, 1.57079632679489655800e+00, x); r = __builtin_fma(-k, 6.12323399573676603587e-17, r);
    const double r2 = r * r;
    double sp = -2.50521083854417187751e-08; sp = sp * r2 + 2.75573192239858906526e-06; sp = sp * r2 - 1.98412698412698412698e-04; sp = sp * r2 + 8.33333333333333333333e-03; sp = sp * r2 - 1.66666666666666666667e-01;
    const double sv = r + r * r2 * sp;
    double cp = 2.08767569878680989792e-09; cp = cp * r2 - 2.75573192239858906526e-07; cp = cp * r2 + 2.48015873015873015873e-05; cp = cp * r2 - 1.38888888888888888889e-03; cp = cp * r2 + 4.16666666666666666667e-02; cp = cp * r2 - 0.5;
    const double cv = 1.0 + r2 * cp;
    const int q = ((int)(long long)k) & 3;
    const double so = (q & 1) ? cv : sv, co = (q & 1) ? sv : cv;
    s = (float)((q & 2) ? -so : so); c = (float)(((q + 1) & 2) ? -co : co);
}

__device__ __forceinline__ void tr_item(const float* W, int K, int N, bf16* WT, int row_off, const float* gain, float scale, int mode, LAS float* scr, int item, int lane) {
    const int nblk = N / 64, kb = item / nblk, nb = item % nblk, k0 = 32 * kb, n0 = 64 * nb;
    const int kk = lane >> 4, n4 = lane & 15;
#pragma unroll
    for (int i = 0; i < 8; ++i) { const int k = 4 * i + kk; const float gs = gain ? gain[k0 + k] * scale : scale;
        *(LAS f32x4*)(scr + k * 68 + 4 * n4) = *(const f32x4*)(W + (size_t)(k0 + k) * N + n0 + 4 * n4) * gs; }
    LDS_WAIT();
    const int c = lane & 3;
#pragma unroll
    for (int jj = 0; jj < 4; ++jj) { const int n = (lane >> 2) + 16 * jj; const LAS float* s = scr + (8 * c) * 68 + n;
        v4u o; o.x = pk2(s[0 * 68], s[1 * 68]); o.y = pk2(s[2 * 68], s[3 * 68]); o.z = pk2(s[4 * 68], s[5 * 68]); o.w = pk2(s[6 * 68], s[7 * 68]);
        const int nn = n0 + n; const int orow = mode == 0 ? row_off + nn : (nn < 1024 ? 8 * (nn >> 2) + (nn & 3) : 8 * ((nn - 1024) >> 2) + 4 + (nn & 3));
        *(v4u*)(WT + ((size_t)(orow >> 8) * (K >> 6) + (k0 >> 6)) * 16384 + (size_t)(orow & 255) * 64 + (k0 & 63) + 8 * c) = o; }
    LDS_WAIT();
}

struct Args { const float* in[25]; float* out; unsigned char* ws; double inv[8]; int ph_lo, ph_hi, grid, pad; };
static_assert(sizeof(Args) == 25 * 8 + 8 + 8 + 64 + 16, "Args has no padding");
#define GAS __attribute__((address_space(1)))
struct ArgsK { const GAS float* in[25]; GAS float* out; GAS unsigned char* ws; double inv[8]; int ph_lo, ph_hi, grid, pad; };
static_assert(sizeof(ArgsK) == sizeof(Args), "ArgsK mirrors Args");
typedef const __attribute__((address_space(4))) ArgsK* kap_t;
__device__ __forceinline__ kap_t kargs() { unsigned long long p = (unsigned long long)__builtin_amdgcn_kernarg_segment_ptr(); asm volatile("" : "+s"(p)); return (kap_t)p; }
#define KIN(k) ((const float*)ap->in[k])

__device__ __forceinline__ void phase0(kap_t ap, LAS unsigned char* lds, int G) {
    const int tid = tid_opq(), lane = tid & 63, wave = __builtin_amdgcn_readfirstlane(tid >> 6);
    unsigned char* ws = (unsigned char*)ap->ws;
    LAS float* scr = (LAS float*)(lds + wave * 16384);
    const int gw = bid_opq() * 8 + wave, NGW = G * 8;
    const float* norm_mix = KIN(2); const float* kv_norm = KIN(12); const float* norm_mlp = KIN(18); const float* norm_ple = KIN(21);
    constexpr int I_GLU = 32 * 32, I_UP = 32 * 64, I_DOWN = 128 * 16, I_SQ = 32 * 16, I_PROJ = 8 * 16, I_KV = 32 * 4;
    constexpr int NITEMS = 2 * I_GLU + 4 * I_UP + 4 * I_DOWN + 4 * I_SQ + 4 * I_PROJ + I_SQ + 2 * I_KV + I_SQ + 2 * I_SQ;
    for (int it = gw; it < NITEMS; it += NGW) {
        int r = it;
        if (r < 2 * I_GLU) { const int l = r / I_GLU; tr_item(KIN(11) + (size_t)l * DM * 2048, DM, 2048, (bf16*)(ws + WS_WGLU) + (size_t)l * 2048 * DM, 0, nullptr, 1.f, 1, scr, r % I_GLU, lane); continue; } r -= 2 * I_GLU;
        if (r < 4 * I_UP) { const int l = r / I_UP; tr_item(KIN(19) + (size_t)l * DM * FF, DM, FF, (bf16*)(ws + WS_WUP) + (size_t)l * FF * DM, 0, norm_mlp + l * DM, 1.f, 0, scr, r % I_UP, lane); continue; } r -= 4 * I_UP;
        if (r < 4 * I_DOWN) { const int l = r / I_DOWN; tr_item(KIN(20) + (size_t)l * FF * DM, FF, DM, (bf16*)(ws + WS_WDOWN) + (size_t)l * DM * FF, 0, nullptr, 1.f, 0, scr, r % I_DOWN, lane); continue; } r -= 4 * I_DOWN;
        if (r < 4 * I_SQ) { const int l = r / I_SQ; tr_item(KIN(22) + (size_t)l * DM * DM, DM, DM, (bf16*)(ws + WS_WGATE) + (size_t)l * DM * DM, 0, norm_ple + l * DM, 1.f, 0, scr, r % I_SQ, lane); continue; } r -= 4 * I_SQ;
        if (r < 4 * I_PROJ) { const int l = r / I_PROJ; tr_item(KIN(23) + (size_t)l * PLE * DM, PLE, DM, (bf16*)(ws + WS_WPROJ) + (size_t)l * DM * PLE, 0, nullptr, 1.f, 0, scr, r % I_PROJ, lane); continue; } r -= 4 * I_PROJ;
        if (r < I_SQ) { tr_item(KIN(15), DM, DM, (bf16*)(ws + WS_WQKV2), 0, norm_mix + 2 * DM, C2, 0, scr, r, lane); continue; } r -= I_SQ;
        if (r < I_KV) { tr_item(KIN(13), DM, 256, (bf16*)(ws + WS_WQKV2), 1024, kv_norm, 1.f, 0, scr, r, lane); continue; } r -= I_KV;
        if (r < I_KV) { tr_item(KIN(14), DM, 256, (bf16*)(ws + WS_WQKV2), 1280, kv_norm, 1.f, 0, scr, r, lane); continue; } r -= I_KV;
        if (r < I_SQ) { tr_item(KIN(15) + (size_t)DM * DM, DM, DM, (bf16*)(ws + WS_WQ3), 0, norm_mix + 3 * DM, C2, 0, scr, r, lane); continue; } r -= I_SQ;
        { const int l = r / I_SQ; tr_item(KIN(17) + (size_t)l * DM * DM, DM, DM, (bf16*)(ws + WS_WO) + (size_t)l * DM * DM, 0, nullptr, 1.f, 0, scr, r % I_SQ, lane); }
    }
    const int gt = bid_opq() * 512 + tid, NGT = G * 512;
    { float* rc = (float*)(ws + WS_ROPE); float* rsn = rc + SEQ * 8;
      for (int i = gt; i < SEQ * 8; i += NGT) { float s, c; sincos_d((double)(i >> 3) * ap->inv[i & 7], s, c); rc[i] = c; rsn[i] = s; } }
    for (int i = gt; i < 2 * 64 * 64; i += NGT) {
        const int l = i >> 12, g = (i >> 6) & 63, n = i & 63;
        unsigned char* tb = ws + WS_S5T + (size_t)l * MiB;
        bf16* BBt = (bf16*)tb; bf16* Cc = (bf16*)(tb + 256 * 1024); float* At = (float*)(tb + 512 * 1024); float* A64 = (float*)(tb + 576 * 1024);
        const double dt = exp((double)KIN(5)[l * 64 + g]);
        const double lr = (double)KIN(3)[i], li = (double)KIN(4)[i];
        const double mag = exp(lr * dt); float sf, cf; sincos_d(li * dt, sf, cf);
        double sd, cd; {
            sd = (double)sf; cd = (double)cf; }
        const double ar = mag * cd, ai = mag * sd, den = lr * lr + li * li, nr = ar - 1.0;
        const double cr = (nr * lr + ai * li) / den, ci = (ai * lr - nr * li) / den;
        At[(g * 64 + n) * 2] = (float)ar; At[(g * 64 + n) * 2 + 1] = (float)ai;
        double pr = ar, pi = ai;
#pragma unroll 1
        for (int s = 0; s < 6; ++s) { const double tr = pr * pr - pi * pi, ti = 2.0 * pr * pi; pr = tr; pi = ti; }
        A64[(g * 64 + n) * 2] = (float)pr; A64[(g * 64 + n) * 2 + 1] = (float)pi;
        const float* bre = KIN(6) + (size_t)i * 16; const float* bim = KIN(7) + (size_t)i * 16; const float* gn = KIN(2) + l * DM + g * 16;
#pragma unroll 1
        for (int h = 0; h < 16; ++h) { const double br = bre[h], bi = bim[h], gg = gn[h];
            BBt[(((size_t)(g * 2 + 0) * 64 + n) * 16) + h] = (bf16)f2bf((float)((cr * br - ci * bi) * gg));
            BBt[(((size_t)(g * 2 + 1) * 64 + n) * 16) + h] = (bf16)f2bf((float)((cr * bi + ci * br) * gg));
            const size_t ci_ = ((size_t)(l * 64 + g) * 16 + h) * 64 + n;
            Cc[((size_t)(g * 16 + h)) * 128 + 2 * n] = (bf16)f2bf(KIN(8)[ci_]); Cc[((size_t)(g * 16 + h)) * 128 + 2 * n + 1] = (bf16)f2bf(-KIN(9)[ci_]); }
    }
    { float* ss = (float*)(ws + WS_SS); bf16* hb2 = (bf16*)(ws + WS_ACT + ACT_HB2);
      for (int m0 = 4 * gw; m0 < MT; m0 += 4 * NGW) {
          f32x4 v[4][4];
#pragma unroll
          for (int r = 0; r < 4; ++r)
#pragma unroll
              for (int j = 0; j < 4; ++j) v[r][j] = ((const f32x4*)(KIN(0) + (size_t)(m0 + r) * DM))[lane + 64 * j];
#pragma unroll
          for (int r = 0; r < 4; ++r) { float s = 0.f;
#pragma unroll
              for (int j = 0; j < 4; ++j) { s += pg8::sumsq4(v[r][j]); v2u w; w.x = pg8::cvt_pk_bf16(v[r][j][0], v[r][j][1]); w.y = pg8::cvt_pk_bf16(v[r][j][2], v[r][j][3]); ((v2u*)(hb2 + (size_t)(m0 + r) * DM))[lane + 64 * j] = w; }
              s = wave_sum(s); if (lane < 16) ss[(size_t)(m0 + r) * 32 + lane] = lane == 0 ? s : 0.f; } } }
}

__device__ __forceinline__ float gelu_tanh(float v) { const float z = v + 0.044715f * v * v * v; return v * __builtin_amdgcn_rcpf(1.0f + __builtin_amdgcn_exp2f(-2.0f * 0.7978845608028654f * pg8::LOG2E * z)); }
template <bool FINAL>
__device__ __forceinline__ void s5_pass(LAS unsigned char* lds, int G, const bf16* base, const float* ss, const unsigned char* tb, const float* gain, const float* dvec, float* St, bf16* Y) {
    const int tid = tid_opq(), lane = tid & 63, wave = __builtin_amdgcn_readfirstlane(tid >> 6), j = lane & 31, hi = lane >> 5;
    const bf16* BBt = (const bf16*)tb; const bf16* Cc = (const bf16*)(tb + 256 * 1024); const float* At = (const float*)(tb + 512 * 1024);
    LAS float* rs = (LAS float*)lds;
    LAS unsigned char* xb = lds + 1024 + wave * 8704;
    const f32x16 zero16 = {0.f, 0.f, 0.f, 0.f, 0.f, 0.f, 0.f, 0.f, 0.f, 0.f, 0.f, 0.f, 0.f, 0.f, 0.f, 0.f};
    const int tlA = 64 * ((j >> 2) & 1) + 4 * (j >> 3) + (j & 3);
    for (int unit = bid_opq(); unit < 256; unit += G) {
        const int b = unit >> 7, c128 = unit & 127, tok0 = b * SEQ + c128 * 128;
        __syncthreads();
        if (tid < 128) rs[tid] = pg8::rstd_of<4>(ss, tok0 + tid);
        __syncthreads();
#pragma unroll 1
        for (int gi = 0; gi < 8; ++gi) {
            const int g = wave + 8 * gi;
            const bf16* abase = base + (size_t)(tok0 + tlA) * DM + g * 16 + 8 * hi;
            v4u arow[4];
#pragma unroll
            for (int tt = 0; tt < 4; ++tt) arow[tt] = *(const v4u*)(abase + (size_t)(16 * tt) * DM);
            bf16x8 bop[2][2]; float ar[2], ai[2], nai[2], xr[2], xi[2];
#pragma unroll
            for (int st = 0; st < 2; ++st) {
#pragma unroll
                for (int c = 0; c < 2; ++c) bop[st][c] = *(const bf16x8*)(BBt + (((size_t)(g * 2 + c) * 64 + st * 32 + j) * 16 + 8 * hi));
                const f32x2 av = *(const f32x2*)(At + (g * 64 + st * 32 + j) * 2); ar[st] = av.x; ai[st] = av.y; nai[st] = -av.y;
                if (FINAL) { const f32x2 cv = *(const f32x2*)(St + (((size_t)(b * 256 + 2 * c128 + hi) * 64 + g) * 64 + st * 32 + j) * 2); xr[st] = cv.x; xi[st] = cv.y; } else { xr[st] = 0.f; xi[st] = 0.f; }
            }
            bf16x8 cop[4]; f32x4 gdv = {0.f, 0.f, 0.f, 0.f};
            const int ch = g * 16 + 4 * (lane >> 4);
            if (FINAL) {
#pragma unroll
                for (int ks = 0; ks < 4; ++ks) cop[ks] = *(const bf16x8*)(Cc + ((size_t)(g * 16 + (lane & 15)) * 128 + 32 * ks + 8 * (lane >> 4)));
                gdv = *(const f32x4*)(gain + ch) * *(const f32x4*)(dvec + ch);
            }
            v2u hvr[4][2];
            if (FINAL) {
#pragma unroll
                for (int tt = 0; tt < 4; ++tt)
#pragma unroll
                    for (int mt = 0; mt < 2; ++mt) hvr[tt][mt] = *(const v2u*)(base + (size_t)(tok0 + 64 * mt + 16 * tt + (lane & 15)) * DM + ch);
            }
#pragma unroll
            for (int tt = 0; tt < 4; ++tt) {
                const v4u a_cur = arow[tt];
                v2u hv[2]; if (FINAL) { hv[0] = hvr[tt][0]; hv[1] = hvr[tt][1]; }
                const float r = rs[tlA + 16 * tt];
                f32x4 u0, u1; pg8::unpack8(a_cur, u0, u1);
                const v4u aw = pg8::pack8(u0 * r, u1 * r); const bf16x8 aop = __builtin_bit_cast(bf16x8, aw);
                f32x16 acc[2][2];
#pragma unroll
                for (int st = 0; st < 2; ++st)
#pragma unroll
                    for (int c = 0; c < 2; ++c) acc[st][c] = __builtin_amdgcn_mfma_f32_32x32x16_bf16(aop, bop[st][c], zero16, 0, 0, 0);
                asm volatile("s_nop 15\n\ts_nop 15\n\ts_nop 15\n\ts_nop 15" : "+v"(acc[0][0]), "+v"(acc[0][1]), "+v"(acc[1][0]), "+v"(acc[1][1]));
#pragma unroll
                for (int q = 0; q < 16; ++q)
#pragma unroll
                    for (int st = 0; st < 2; ++st) {
                        float t0_, t1_, nr, ni;
                        asm("v_fma_f32 %0, %1, %2, %3" : "=v"(t0_) : "v"(nai[st]), "v"(xi[st]), "v"(acc[st][0][q]));
                        asm("v_fma_f32 %0, %1, %2, %3" : "=v"(nr) : "v"(ar[st]), "v"(xr[st]), "v"(t0_));
                        asm("v_fma_f32 %0, %1, %2, %3" : "=v"(t1_) : "v"(ai[st]), "v"(xr[st]), "v"(acc[st][1][q]));
                        asm("v_fma_f32 %0, %1, %2, %3" : "=v"(ni) : "v"(ar[st]), "v"(xi[st]), "v"(t1_));
                        xr[st] = nr; xi[st] = ni;
                        if (FINAL) *(LAS unsigned*)(xb + (16 * hi + q) * 272 + (st * 32 + j) * 4) = pg8::cvt_pk_bf16(nr, ni);
                    }
                if (FINAL) {
                    LDS_WAIT();
#pragma unroll
                    for (int mt = 0; mt < 2; ++mt) {
                        f32x4 d = {0.f, 0.f, 0.f, 0.f};
#pragma unroll
                        for (int ks = 0; ks < 4; ++ks) { const bf16x8 xop = *(const LAS bf16x8*)(xb + (16 * mt + (lane & 15)) * 272 + (32 * ks + 8 * (lane >> 4)) * 2); d = __builtin_amdgcn_mfma_f32_16x16x32_bf16(cop[ks], xop, d, 0, 0, 0); }
                        const int tl2 = 64 * mt + 16 * tt + (lane & 15);
                        const float r2 = rs[tl2];
                        f32x4 hvf; hvf[0] = pg8::bflo(hv[mt].x); hvf[1] = pg8::bfhi(hv[mt].x); hvf[2] = pg8::bflo(hv[mt].y); hvf[3] = pg8::bfhi(hv[mt].y);
                        f32x4 y = d + gdv * (hvf * r2);
#pragma unroll
                        for (int e = 0; e < 4; ++e) y[e] = gelu_tanh(y[e]);
                        v2u w; w.x = pg8::cvt_pk_bf16(y[0], y[1]); w.y = pg8::cvt_pk_bf16(y[2], y[3]);
                        *(v2u*)(Y + (size_t)(tok0 + tl2) * DM + ch) = w;
                    }
                    LDS_WAIT();
                }
            }
            if (!FINAL) {
#pragma unroll
                for (int st = 0; st < 2; ++st) { f32x2 o; o.x = xr[st]; o.y = xi[st]; *(f32x2*)(St + (((size_t)(b * 256 + 2 * c128 + hi) * 64 + g) * 64 + st * 32 + j) * 2) = o; }
            }
        }
    }
}
__device__ __forceinline__ void s5_carry(int G, const unsigned char* tb, float* St) {
    const int tid = tid_opq(), lane = tid & 63;
    if (tid >= 64) return;
    const float* A64 = (const float*)(tb + 576 * 1024);
    for (int bg = bid_opq(); bg < 128; bg += G) {
        const int b = bg >> 6, g = bg & 63;
        const f32x2 av = *(const f32x2*)(A64 + (g * 64 + lane) * 2);
        float cr = 0.f, ci = 0.f; const float nay = -av.y;
        float* p = St + (((size_t)(b * 256) * 64 + g) * 64 + lane) * 2;
#pragma unroll 1
        for (int k = 0; k < 256; k += 8) {
            f32x2 s[8];
#pragma unroll
            for (int u = 0; u < 8; ++u) s[u] = *(const f32x2*)(p + (size_t)(k + u) * 8192);
#pragma unroll
            for (int u = 0; u < 8; ++u) { f32x2 o; o.x = cr; o.y = ci; *(f32x2*)(p + (size_t)(k + u) * 8192) = o;
                float t0_, t1_, nr, ni;
                asm("v_fma_f32 %0, %1, %2, %3" : "=v"(t0_) : "v"(nay), "v"(ci), "v"(s[u].x));
                asm("v_fma_f32 %0, %1, %2, %3" : "=v"(nr) : "v"(av.x), "v"(cr), "v"(t0_));
                asm("v_fma_f32 %0, %1, %2, %3" : "=v"(t1_) : "v"(av.y), "v"(cr), "v"(s[u].y));
                asm("v_fma_f32 %0, %1, %2, %3" : "=v"(ni) : "v"(av.x), "v"(ci), "v"(t1_));
                cr = nr; ci = ni; }
        }
    }
}

__device__ __forceinline__ void attn_phase(LAS unsigned char* lds, int G, const bf16* Q, const bf16* Kb, const bf16* Vt, bf16* O, const float* sinks) {
    constexpr int KS = 144, VS = 528;
    const int tid = tid_opq(), lane = tid & 63, wave = __builtin_amdgcn_readfirstlane(tid >> 6), j = lane & 31, hi = lane >> 5;
    LAS unsigned char* Ksm = lds; LAS unsigned char* Vsm = lds + 256 * KS;
    const f32x16 zero16 = {0.f, 0.f, 0.f, 0.f, 0.f, 0.f, 0.f, 0.f, 0.f, 0.f, 0.f, 0.f, 0.f, 0.f, 0.f, 0.f};
    const int prow = 16 * ((j >> 2) & 1) + 4 * (j >> 3) + (j & 3);
    for (int unit = bid_opq(); unit < 1024; unit += G) {
        const int kh = unit & 3, nb = (unit >> 2) & 127, b = unit >> 9;
        __syncthreads();
#pragma unroll
        for (int it = 0; it < 4; ++it) { const int idx = tid + 512 * it, row = idx >> 3, ch = idx & 7, pos = nb * 128 - 128 + row;
            v4u v = {0u, 0u, 0u, 0u}; if (pos >= 0) v = *(const v4u*)(Kb + ((size_t)(b * SEQ + pos) * 256 + kh * 64 + ch * 8));
            *(LAS v4u*)(Ksm + row * KS + ch * 16) = v; }
#pragma unroll
        for (int it = 0; it < 4; ++it) { const int idx = tid + 512 * it, d = idx >> 5, ch = idx & 31, pos0 = nb * 128 - 128 + ch * 8;
            v4u v = {0u, 0u, 0u, 0u}; if (pos0 >= 0) v = *(const v4u*)(Vt + ((size_t)((b * 4 + kh) * 64 + d) * SEQ + pos0));
            *(LAS v4u*)(Vsm + d * VS + ch * 16) = v; }
        __syncthreads();
        const int hq = kh * 4 + (wave >> 1), qh = wave & 1;
        const float sink2 = sinks[hq] * pg8::LOG2E;
#pragma unroll 1
        for (int qt = 0; qt < 2; ++qt) {
            const int qi = 64 * qh + 32 * qt + j, kt0 = 2 * qh + qt;
            const size_t qrow = (size_t)(b * SEQ + nb * 128 + qi);
            bf16x8 qop[4];
#pragma unroll
            for (int ks = 0; ks < 4; ++ks) qop[ks] = *(const bf16x8*)(Q + qrow * DM + hq * 64 + 16 * ks + 8 * hi);
            f32x16 s[5];
#pragma unroll
            for (int t = 0; t < 5; ++t) { s[t] = zero16;
#pragma unroll
                for (int ks = 0; ks < 4; ++ks) { const bf16x8 kop = *(const LAS bf16x8*)(Ksm + (32 * (kt0 + t) + prow) * KS + (16 * ks + 8 * hi) * 2); s[t] = __builtin_amdgcn_mfma_f32_32x32x16_bf16(kop, qop[ks], s[t], 0, 0, 0); } }
            float m = sink2;
#pragma unroll
            for (int t = 0; t < 5; ++t)
#pragma unroll
                for (int r = 0; r < 16; ++r) { const int jj = 32 * (kt0 + t) + 16 * hi + r; const bool ok = (jj > qi) && (jj <= qi + 128) && (nb > 0 || jj >= 128);
                    s[t][r] = ok ? s[t][r] : -INFINITY; m = fmaxf(m, s[t][r]); }
            m = fmaxf(m, __shfl_xor(m, 32));
            float l = 0.f;
#pragma unroll
            for (int t = 0; t < 5; ++t)
#pragma unroll
                for (int r = 0; r < 16; ++r) { const float p = __builtin_amdgcn_exp2f(s[t][r] - m); s[t][r] = p; l += p; }
            l += __shfl_xor(l, 32); l += __builtin_amdgcn_exp2f(sink2 - m);
            f32x16 o[2]; o[0] = zero16; o[1] = zero16;
#pragma unroll
            for (int t = 0; t < 5; ++t)
#pragma unroll
                for (int hf = 0; hf < 2; ++hf) {
                    v4u pw; pw.x = pg8::cvt_pk_bf16(s[t][8 * hf + 0], s[t][8 * hf + 1]); pw.y = pg8::cvt_pk_bf16(s[t][8 * hf + 2], s[t][8 * hf + 3]); pw.z = pg8::cvt_pk_bf16(s[t][8 * hf + 4], s[t][8 * hf + 5]); pw.w = pg8::cvt_pk_bf16(s[t][8 * hf + 6], s[t][8 * hf + 7]);
                    const bf16x8 pop = __builtin_bit_cast(bf16x8, pw);
#pragma unroll
                    for (int dt = 0; dt < 2; ++dt) { const bf16x8 vop = *(const LAS bf16x8*)(Vsm + (32 * dt + j) * VS + (32 * (kt0 + t) + 16 * hi + 8 * hf) * 2); o[dt] = __builtin_amdgcn_mfma_f32_32x32x16_bf16(vop, pop, o[dt], 0, 0, 0); }
                }
            const float inv = 1.0f / l;
#pragma unroll
            for (int dt = 0; dt < 2; ++dt)
#pragma unroll
                for (int a4 = 0; a4 < 4; ++a4) { v2u w; w.x = pg8::cvt_pk_bf16(o[dt][4 * a4] * inv, o[dt][4 * a4 + 1] * inv); w.y = pg8::cvt_pk_bf16(o[dt][4 * a4 + 2] * inv, o[dt][4 * a4 + 3] * inv);
                    *(v2u*)(O + qrow * DM + hq * 64 + 32 * dt + 8 * a4 + 4 * hi) = w; }
        }
    }
}

__device__ __forceinline__ void pconv(const float* p, bf16* pb, int G) {
    const int gt = bid_opq() * 512 + tid_opq(), NGT = G * 512;
    for (int i = gt; i < MT * PLE / 4; i += 4 * NGT) {
        f32x4 v[4];
#pragma unroll
        for (int u = 0; u < 4; ++u) { const int k = i + u * NGT; v[u] = k < MT * PLE / 4 ? ((const f32x4*)p)[k] : (f32x4){0.f, 0.f, 0.f, 0.f}; }
#pragma unroll
        for (int u = 0; u < 4; ++u) { const int k = i + u * NGT; if (k < MT * PLE / 4) { v2u w; w.x = pg8::cvt_pk_bf16(v[u][0], v[u][1]); w.y = pg8::cvt_pk_bf16(v[u][2], v[u][3]); ((v2u*)pb)[k] = w; } } }
}
__device__ __forceinline__ void final_norm(const bf16* hb, float* out, const float* gain, int G) {
    const int tid = tid_opq(), lane = tid & 63, wave = tid >> 6; const int gw = bid_opq() * 8 + wave, NGW = G * 8;
    f32x4 gv[4];
#pragma unroll
    for (int c = 0; c < 2; ++c) { gv[2 * c] = *(const f32x4*)(gain + 8 * lane + 512 * c); gv[2 * c + 1] = *(const f32x4*)(gain + 8 * lane + 512 * c + 4); }
    for (int m = gw; m < MT; m += NGW) { f32x4 v[4]; float s = 0.f;
#pragma unroll
        for (int c = 0; c < 2; ++c) { pg8::unpack8(*(const v4u*)(hb + (size_t)m * DM + 8 * lane + 512 * c), v[2 * c], v[2 * c + 1]); s += pg8::sumsq4(v[2 * c]) + pg8::sumsq4(v[2 * c + 1]); }
        const float rstd = 1.0f / sqrtf(wave_sum(s) * (1.0f / DM) + pg8::RMS_EPS);
#pragma unroll
        for (int c = 0; c < 2; ++c) { float* o = out + (size_t)m * DM + 8 * lane + 512 * c; *(f32x4*)o = v[2 * c] * rstd * gv[2 * c]; *(f32x4*)(o + 4) = v[2 * c + 1] * rstd * gv[2 * c + 1]; } }
}

#define XB_TMO      128
#define XB_XCNT(j)  (256  + 64 * (j))
#define XB_XSUB(j)  (1280 + 64 * (j))
#define XB_XGEN(j)  (2304 + 64 * (j))
#define XB_TOP      3328
#define XB_TOPGEN   3392
#define XCD_BAR_WORDS 3456
#define XB_SPIN_CAP (1u << 18)

__device__ __forceinline__ unsigned xb_ld(unsigned* p)              { return __hip_atomic_load(p, __ATOMIC_RELAXED, __HIP_MEMORY_SCOPE_AGENT); }
__device__ __forceinline__ unsigned xb_add(unsigned* p, unsigned v) { return __hip_atomic_fetch_add(p, v, __ATOMIC_RELAXED, __HIP_MEMORY_SCOPE_AGENT); }
__device__ __forceinline__ unsigned xb_xcc_id() { return (unsigned)__builtin_amdgcn_s_getreg((3 << 11) | 20) & 0xFu; }
#define XB_SPIN(cond, bar) do { unsigned _sp = 0; while (cond) { __builtin_amdgcn_s_sleep(1); \
    if ((++_sp & 255u) == 0u) { if (xb_ld(&(bar)[XB_TMO])) break; if (_sp > XB_SPIN_CAP) { atomicAdd(&(bar)[XB_TMO], 1u); break; } } } } while (0)

struct XcdBarrier {
    unsigned* bar; unsigned x;
    volatile LAS unsigned* st;
};

__device__ __forceinline__ XcdBarrier xcd_barrier_post(unsigned* bar, volatile LAS unsigned* st) {
    XcdBarrier b; b.bar = bar; b.x = xb_xcc_id(); b.st = st;
    if (threadIdx.x == 0) (void)xb_add(&bar[XB_XCNT(b.x)], 1u);
    return b;
}
__device__ __forceinline__ void xcd_barrier_complete(unsigned* bar, unsigned x, unsigned& nloc, unsigned& nx) {
    const unsigned G = gridDim.x * gridDim.y * gridDim.z;
    unsigned sum, cnt, mine, sp = 0u;
    for (;;) {
        sum = 0u; cnt = 0u; mine = 0u;
#pragma unroll
        for (unsigned j = 0; j < 16; ++j) { const unsigned c = xb_ld(&bar[XB_XCNT(j)]); sum += c; cnt += (c > 0u) ? 1u : 0u; mine = (j == x) ? c : mine; }
        if (sum == G) break;
        __builtin_amdgcn_s_sleep(1);
        if ((++sp & 255u) == 0u) { if (xb_ld(&bar[XB_TMO])) break; if (sp > XB_SPIN_CAP) { atomicAdd(&bar[XB_TMO], 1u); break; } }
    }
    nloc = mine > 0u ? mine : 1u; nx = cnt > 0u ? cnt : 1u;
}

__device__ __forceinline__ void xcd_barrier(const XcdBarrier& b) {
    asm volatile("s_waitcnt vmcnt(0)" ::: "memory");
    __syncthreads();
    if (threadIdx.x == 0) {
        unsigned* bar = b.bar;
        __builtin_amdgcn_s_waitcnt(0);
        unsigned nloc = b.st[0], nx = b.st[1];
        if (nloc == 0u) { xcd_barrier_complete(bar, b.x, nloc, nx); b.st[0] = nloc; b.st[1] = nx; }
        const unsigned old = xb_add(&bar[XB_XSUB(b.x)], 1u);
        const unsigned gen = old / nloc;
        if (old + 1u == (gen + 1u) * nloc) {
            __builtin_amdgcn_fence(__ATOMIC_RELEASE, "agent");
            asm volatile("s_waitcnt vmcnt(0)" ::: "memory");
            const unsigned og = xb_add(&bar[XB_TOP], 1u);
            const unsigned tg = og / nx;
            if (og + 1u == (tg + 1u) * nx) xb_add(&bar[XB_TOPGEN], 1u);
            else XB_SPIN(xb_ld(&bar[XB_TOPGEN]) == tg, bar);
            __builtin_amdgcn_fence(__ATOMIC_ACQUIRE, "agent");
            xb_add(&bar[XB_XGEN(b.x)], 1u);
            asm volatile("s_waitcnt vmcnt(0)" ::: "memory");
        } else {
            XB_SPIN(xb_ld(&bar[XB_XGEN(b.x)]) == gen, bar);
            __builtin_amdgcn_fence(__ATOMIC_ACQUIRE, "agent");
            asm volatile("s_waitcnt vmcnt(0)" ::: "memory");
        }
    }
    __syncthreads();
}

__device__ __forceinline__ void xcd_arrive(const XcdBarrier& b) {
    asm volatile("s_waitcnt vmcnt(0)" ::: "memory");
    __syncthreads();
    if (threadIdx.x == 0) {
        unsigned* bar = b.bar;
        __builtin_amdgcn_s_waitcnt(0);
        unsigned nloc = b.st[0], nx = b.st[1];
        if (nloc == 0u) { xcd_barrier_complete(bar, b.x, nloc, nx); b.st[0] = nloc; b.st[1] = nx; }
        const unsigned old = xb_add(&bar[XB_XSUB(b.x)], 1u);
        const unsigned gen = old / nloc;
        if (old + 1u == (gen + 1u) * nloc) {
            __builtin_amdgcn_fence(__ATOMIC_RELEASE, "agent");
            asm volatile("s_waitcnt vmcnt(0)" ::: "memory");
            const unsigned og = xb_add(&bar[XB_TOP], 1u);
            const unsigned tg = og / nx;
            if (og + 1u == (tg + 1u) * nx) xb_add(&bar[XB_TOPGEN], 1u);
            else XB_SPIN(xb_ld(&bar[XB_TOPGEN]) == tg, bar);
            __builtin_amdgcn_fence(__ATOMIC_ACQUIRE, "agent");
            xb_add(&bar[XB_XGEN(b.x)], 1u);
            asm volatile("s_waitcnt vmcnt(0)" ::: "memory");
        }
        b.st[3] = gen;
    }
}
__device__ __forceinline__ void xcd_wait(const XcdBarrier& b) {
    asm volatile("s_waitcnt vmcnt(0)" ::: "memory");
    __syncthreads();
    if (threadIdx.x == 0) {
        unsigned* bar = b.bar; const unsigned gen = b.st[3];
        XB_SPIN(xb_ld(&bar[XB_XGEN(b.x)]) == gen, bar);
        __builtin_amdgcn_fence(__ATOMIC_ACQUIRE, "agent");
        asm volatile("s_waitcnt vmcnt(0)" ::: "memory");
    }
    __syncthreads();
}

__global__ void __launch_bounds__(512, 2) yoco_fwd(Args a_bytes) {
    extern __shared__ __attribute__((aligned(16))) unsigned char lds_raw[];
    LAS unsigned char* lds = (LAS unsigned char*)lds_raw;
    cg::grid_group grid = cg::this_grid();
    int ph = 0, lo, hi;
    { kap_t ap = kargs(); lo = ap->ph_lo; hi = ap->ph_hi; }
    volatile LAS unsigned* bst = (volatile LAS unsigned*)(lds + 131072 + 64);
    if (threadIdx.x < 4) bst[threadIdx.x] = 0u;
    __syncthreads();
    XcdBarrier xbar; { kap_t ap = kargs(); xbar = xcd_barrier_post((unsigned*)((unsigned char*)ap->ws + WS_CTL), bst); }
#ifndef PROBE_DUP
#define PROBE_DUP 0ull
#endif
#if PROBE_DUP
#define RUN() for (int rep_ = 0, nrep_ = (lo <= ph && ph < hi) ? 1 + (int)((PROBE_DUP >> ph) & 1ull) : 0; rep_ < nrep_; ++rep_) if (rep_ == 0 || (grid.sync(), true))
#else
#define RUN() (lo <= ph && ph < hi)
#endif
#if PROBE_DUP
#define IFRUN RUN()
#else
#define IFRUN if (RUN())
#endif
#define SEAM() do { if (lo <= ph && ph + 1 < hi) { if (ph == 0) grid.sync(); else xcd_barrier(xbar); } ++ph; } while (0)
#define SEAM_WITH(work) do { const bool split_ = (lo <= ph && ph + 1 < hi); if (split_) xcd_arrive(xbar); IFRUN { PHASE_VARS; work; } if (split_) xcd_wait(xbar); ++ph; } while (0)
#define PHASE_VARS kap_t ap = kargs(); const int G = ap->grid; unsigned char* ws = (unsigned char*)ap->ws; \
    float* ssb = (float*)(ws + WS_SS); float* ss_in = ssb + (size_t)((3 * layer) & 3) * MT * 32; float* ss_mix = ssb + (size_t)((3 * layer + 1) & 3) * MT * 32; float* ss_mlp = ssb + (size_t)((3 * layer + 2) & 3) * MT * 32; float* ss_ple = ssb + (size_t)((3 * layer + 3) & 3) * MT * 32; (void)ss_mix; (void)ss_mlp; (void)ss_ple; \
    const bf16* hin = (const bf16*)(ws + WS_ACT + ACT_HB2); (void)hin;
    IFRUN { kap_t ap = kargs(); phase0(ap, lds, ap->grid); }
    SEAM();
#pragma unroll 1
    for (int layer = 0; layer < 4; ++layer) {
        if (layer < 2) {
            IFRUN { PHASE_VARS; s5_pass<false>(lds, G, hin, ss_in, ws + WS_S5T + (size_t)layer * MiB, KIN(2) + layer * DM, KIN(10) + layer * DM, (float*)(ws + WS_ACT + ACT_ST), (bf16*)(ws + WS_ACT + ACT_Y)); }
            SEAM();
            IFRUN { PHASE_VARS; s5_carry(G, ws + WS_S5T + (size_t)layer * MiB, (float*)(ws + WS_ACT + ACT_ST)); }
            SEAM();
            IFRUN { PHASE_VARS; s5_pass<true>(lds, G, hin, ss_in, ws + WS_S5T + (size_t)layer * MiB, KIN(2) + layer * DM, KIN(10) + layer * DM, (float*)(ws + WS_ACT + ACT_ST), (bf16*)(ws + WS_ACT + ACT_Y)); }
            SEAM();
            IFRUN { PHASE_VARS;
                pg8::Gemm g{(const bf16*)(ws + WS_ACT + ACT_Y), (const bf16*)(ws + WS_WGLU) + (size_t)layer * 2048 * DM, MT, 2048, DM}; pg8::StaticOrder S; S.init(MT, 2048, G, bid_opq());
                pg8::EpiGlu E{hin, (bf16*)(ws + WS_HB), ss_mix};
                pg8::gemm_phase<pg8::EpiGlu, pg8::StaticOrder, true, true>(lds, g, S, E); }
            SEAM_WITH(pconv(KIN(1) + (size_t)layer * MT * PLE, (bf16*)(ws + WS_PB), G));
        } else {
            IFRUN { PHASE_VARS; const int j = layer - 2; const int N = j == 0 ? 1536 : 1024;
                pg8::Gemm g{(const bf16*)(ws + WS_ACT + ACT_HB2), (const bf16*)(ws + (j == 0 ? WS_WQKV2 : WS_WQ3)), MT, N, DM}; pg8::StaticOrder S; S.init(MT, N, G, bid_opq());
                pg8::EpiQKV E{(bf16*)(ws + WS_ACT + ACT_Q), (bf16*)(ws + WS_K), (bf16*)(ws + WS_VT), ss_in, (const float*)(ws + WS_ROPE), (const float*)(ws + WS_ROPE) + SEQ * 8};
                pg8::gemm_phase<pg8::EpiQKV, pg8::StaticOrder, true, true>(lds, g, S, E); }
            SEAM();
            IFRUN { PHASE_VARS; attn_phase(lds, G, (const bf16*)(ws + WS_ACT + ACT_Q), (const bf16*)(ws + WS_K), (const bf16*)(ws + WS_VT), (bf16*)(ws + WS_ACT + ACT_O), KIN(16) + (layer - 2) * 16); }
            SEAM();
            IFRUN { PHASE_VARS;
                pg8::Gemm g{(const bf16*)(ws + WS_ACT + ACT_O), (const bf16*)(ws + WS_WO) + (size_t)(layer - 2) * DM * DM, MT, DM, DM}; pg8::StaticOrder S; S.init(MT, DM, G, bid_opq());
                pg8::EpiRes<0> E{hin, (bf16*)(ws + WS_HB), ss_mix, nullptr};
                pg8::gemm_phase<pg8::EpiRes<0>, pg8::StaticOrder, true, true>(lds, g, S, E); }
            SEAM_WITH(pconv(KIN(1) + (size_t)layer * MT * PLE, (bf16*)(ws + WS_PB), G));
        }
        IFRUN { PHASE_VARS; pg8::Gemm g{(const bf16*)(ws + WS_HB), (const bf16*)(ws + WS_WUP) + (size_t)layer * FF * DM, MT, FF, DM}; pg8::StaticOrder S; S.init(MT, FF, G, bid_opq());
            pg8::EpiUp E{(bf16*)(ws + WS_ACT)}; pg8::gemm_phase<pg8::EpiUp, pg8::StaticOrder, true, true>(lds, g, S, E); }
        SEAM();
        IFRUN { PHASE_VARS; pg8::Gemm g{(const bf16*)(ws + WS_ACT), (const bf16*)(ws + WS_WDOWN) + (size_t)layer * DM * FF, MT, DM, FF}; pg8::StaticOrder S; S.init(MT, DM, G, bid_opq());
            if (layer < 2) { pg8::EpiRes<8> E{(const bf16*)(ws + WS_HB), (bf16*)(ws + WS_HB), ss_mlp, ss_mix}; pg8::gemm_phase<pg8::EpiRes<8>, pg8::StaticOrder, true, true, true>(lds, g, S, E); }
            else { pg8::EpiRes<4> E{(const bf16*)(ws + WS_HB), (bf16*)(ws + WS_HB), ss_mlp, ss_mix}; pg8::gemm_phase<pg8::EpiRes<4>, pg8::StaticOrder, true, true, true>(lds, g, S, E); } }
        { const bool split = (lo <= ph && ph + 1 < hi);
          if (split) xcd_arrive(xbar);
          IFRUN { PHASE_VARS; pg8::Gemm g{(const bf16*)(ws + WS_PB), (const bf16*)(ws + WS_WPROJ) + (size_t)layer * DM * PLE, MT, DM, PLE}; pg8::StaticOrder S; S.init(MT, DM, G, bid_opq());
              pg8::EpiPP E{(bf16*)(float*)ap->out};
              pg8::gemm_phase<pg8::EpiPP, pg8::StaticOrder, true, true>(lds, g, S, E); }
          if (split) xcd_wait(xbar);
          ++ph; }
        IFRUN { PHASE_VARS; pg8::Gemm g{(const bf16*)(ws + WS_HB), (const bf16*)(ws + WS_WGATE) + (size_t)layer * DM * DM, MT, DM, DM}; pg8::StaticOrder S; S.init(MT, DM, G, bid_opq());
            pg8::EpiGate E{(const bf16*)(ws + WS_HB), (bf16*)(ws + WS_ACT + ACT_HB2), ss_ple, ss_mlp, (const bf16*)(float*)ap->out};
            pg8::gemm_phase<pg8::EpiGate, pg8::StaticOrder, true, true>(lds, g, S, E); }
        SEAM();
    }
    IFRUN { kap_t ap = kargs(); final_norm((const bf16*)((unsigned char*)ap->ws + WS_ACT + ACT_HB2), (float*)ap->out, KIN(24), ap->grid); }
#undef RUN
#undef SEAM
#undef PHASE_VARS
}

extern "C" void kernel_launch(void* const* d_in, const int* in_sizes, int n_in, void* d_out, int out_size, void* d_ws, size_t ws_size, hipStream_t stream) {
    static int grid = 0;
    if (grid == 0) {
        if (n_in != 25 || in_sizes[0] != MT * DM || out_size != MT * DM || ws_size < WS_END) { fprintf(stderr, "kernel_launch: unexpected shapes (n_in %d, in0 %d, out %d, ws %zu); nothing launched\n", n_in, n_in > 0 ? in_sizes[0] : -1, out_size, ws_size); grid = -1; return; }
        int dev = 0, cus = 0, per_cu = 0;
        if (hipGetDevice(&dev) != hipSuccess || hipDeviceGetAttribute(&cus, hipDeviceAttributeMultiprocessorCount, dev) != hipSuccess) { grid = -1; return; }
        if (hipFuncSetAttribute((const void*)yoco_fwd, hipFuncAttributeMaxDynamicSharedMemorySize, LDS_BYTES) != hipSuccess) { fprintf(stderr, "kernel_launch: hipFuncSetAttribute failed\n"); grid = -1; return; }
        if (hipOccupancyMaxActiveBlocksPerMultiprocessor(&per_cu, (const void*)yoco_fwd, 512, LDS_BYTES) != hipSuccess || per_cu < 1) { fprintf(stderr, "kernel_launch: occupancy query reports %d workgroups per CU\n", per_cu); per_cu = 1; }
        (void)hipGetLastError();
        grid = cus;
    }
    if (grid < 0) return;
    Args a{};
    for (int i = 0; i < 25; ++i) a.in[i] = (const float*)d_in[i];
    a.out = (float*)d_out; a.ws = (unsigned char*)d_ws;
    for (int i = 0; i < 8; ++i) a.inv[i] = pow(500000.0, -(double)(2 * i) / 16.0);
#if MK_SINGLE
    if (hipMemsetAsync((char*)d_ws + WS_CTL, 0, 16384, stream) != hipSuccess) { fprintf(stderr, "kernel_launch: hipMemsetAsync failed\n"); return; }
    a.ph_lo = 0; a.ph_hi = NPHASE; a.grid = grid;
    void* args[] = {&a};
    hipError_t e = hipLaunchCooperativeKernel((const void*)yoco_fwd, dim3(grid), dim3(512), args, LDS_BYTES, stream);
    if (e != hipSuccess) fprintf(stderr, "kernel_launch: cooperative launch failed: %s (grid %d)\n", hipGetErrorString(e), grid);
#else
    a.grid = grid; for (int p = 0; p < NPHASE; ++p) { a.ph_lo = p; a.ph_hi = p + 1; hipLaunchKernelGGL(yoco_fwd, dim3(grid), dim3(512), LDS_BYTES, stream, a); }
#endif
}
```

```cpp
#include <hip/hip_runtime.h>
#include <hip/hip_cooperative_groups.h>
#include <cstdio>
#include <cstdint>
#include <cmath>
namespace cg = cooperative_groups;
#ifndef MK_SINGLE
#define MK_SINGLE 1
#endif
namespace pg8 {
#define PG8_LAS __attribute__((address_space(3)))
typedef unsigned short bf16_t;
typedef short bf16x8 __attribute__((ext_vector_type(8)));
typedef float f32x4 __attribute__((ext_vector_type(4)));
typedef unsigned u32x4 __attribute__((ext_vector_type(4)));
constexpr int BM = 256, BK = 64, HALF = 128, HTB = HALF * BK * 2  , STAGE_BYTES = 8 * HTB, NXCD = 8, WGM = 8;

__host__ __device__ __forceinline__ int lds_byte(int r, int c) { const int st = (r >> 4) * 2 + (c >> 5), rr = r & 15, cc = c & 31, ob = rr * 64 + cc * 2; return st * 1024 + (ob ^ (((ob >> 9) & 1) << 5)); }
__host__ __device__ __forceinline__ void stage_rc(int b, int& R, int& C) { const int st = b / 1024, sb = b % 1024, swz = sb ^ (((sb >> 9) & 1) << 5); R = (st >> 1) * 16 + swz / 64; C = (st & 1) * 32 + (swz % 64) / 2; }
__host__ __device__ __forceinline__ int perm32(int rho) { const int n = rho >> 4, i = rho & 15; return 8 * (i >> 2) + 4 * n + (i & 3); }

struct Unit { int pm, pn; };
struct Gemm { const bf16_t* A; const bf16_t* Bt; int M, N, K; };

struct StaticOrder {
    int nM, nN, nwg, G, c;
    __host__ __device__ void init(int M, int N, int G_, int c_) { nM = M / BM; nN = N / BM; nwg = nM * nN; G = G_; c = c_; }
    __host__ __device__ bool next(int i, Unit& u) const {
        const long L = (long)i * G + c; if (L >= nwg) return false;
        int wgid = (int)L; { const int q = nwg / NXCD, r = nwg % NXCD, xcd = wgid % NXCD, off = wgid / NXCD; wgid = (xcd < r ? xcd * (q + 1) : r * (q + 1) + (xcd - r) * q) + off; }
        const int nig = WGM * nN, gid = wgid / nig, fm = gid * WGM, gsz = (nM - fm) < WGM ? (nM - fm) : WGM;
        u.pm = fm + ((wgid % nig) % gsz); u.pn = (wgid % nig) / gsz; return true;
    }
    __device__ __forceinline__ void a_ready(const Unit&) const {}
    __device__ __forceinline__ void done(const Unit&) const {}
};

typedef float f32x2_cv __attribute__((ext_vector_type(2))); typedef __bf16 bf16x2_cv __attribute__((ext_vector_type(2)));
__device__ __forceinline__ unsigned cvt_pk_bf16(float lo, float hi) { const f32x2_cv v = {lo, hi}; const bf16x2_cv b = __builtin_convertvector(v, bf16x2_cv); return __builtin_bit_cast(unsigned, b); }
typedef float f32x2 __attribute__((ext_vector_type(2)));
typedef unsigned u32x2 __attribute__((ext_vector_type(2)));
constexpr float RMS_EPS = 1e-6f, LOG2E = 1.4426950408889634f;
template <int NQ> __device__ __forceinline__ float rstd_of(const float* ss, int row) { const f32x4* p = (const f32x4*)(ss + (size_t)row * 32); float t = 0.f;
#pragma unroll
    for (int i = 0; i < NQ; ++i) { const f32x4 v = p[i]; t += (v[0] + v[1]) + (v[2] + v[3]); }
    return __builtin_amdgcn_rsqf(t * (1.0f / 1024.0f) + RMS_EPS); }
template <int NQ> __device__ __forceinline__ float rstd_epi(const float* ss, int row, int fq) { const f32x4* p = (const f32x4*)(ss + (size_t)row * 32) + fq; f32x4 v = p[0]; float t = (v[0] + v[1]) + (v[2] + v[3]);
    if (NQ == 8) { v = p[4]; t += (v[0] + v[1]) + (v[2] + v[3]); }
    t += __shfl_xor(t, 16); t += __shfl_xor(t, 32);
    return __builtin_amdgcn_rsqf(t * (1.0f / 1024.0f) + RMS_EPS); }
__device__ __forceinline__ float bflo(unsigned w) { return __builtin_bit_cast(float, w << 16); }
__device__ __forceinline__ float bfhi(unsigned w) { return __builtin_bit_cast(float, w & 0xffff0000u); }
__device__ __forceinline__ void unpack8(u32x4 w, f32x4& a, f32x4& b) { a[0] = bflo(w.x); a[1] = bfhi(w.x); a[2] = bflo(w.y); a[3] = bfhi(w.y); b[0] = bflo(w.z); b[1] = bfhi(w.z); b[2] = bflo(w.w); b[3] = bfhi(w.w); }
__device__ __forceinline__ float sumsq_pk(unsigned w) { const float a = bflo(w), b = bfhi(w); return a * a + b * b; }
__device__ __forceinline__ float sigmoidf_(float v) { return __builtin_amdgcn_rcpf(1.0f + __builtin_amdgcn_exp2f(-LOG2E * v)); }
__device__ __forceinline__ float sumsq4(f32x4 v) { return (v[0] * v[0] + v[1] * v[1]) + (v[2] * v[2] + v[3] * v[3]); }
__device__ __forceinline__ u32x4 pack8(f32x4 v0, f32x4 v1) { u32x4 w; w.x = cvt_pk_bf16(v0[0], v0[1]); w.y = cvt_pk_bf16(v0[2], v0[3]); w.z = cvt_pk_bf16(v1[0], v1[1]); w.w = cvt_pk_bf16(v1[2], v1[3]); return w; }

template <int NQ> __device__ __forceinline__ void slots_issue(const float* ss, int row, int fq, f32x4 (&v)[2]) { const f32x4* p = (const f32x4*)(ss + (size_t)row * 32) + fq; v[0] = p[0]; if (NQ == 8) v[1] = p[4]; }
template <int NQ> __device__ __forceinline__ float slots_rstd(const f32x4 (&v)[2]) { float t = (v[0][0] + v[0][1]) + (v[0][2] + v[0][3]); if (NQ == 8) t += (v[1][0] + v[1][1]) + (v[1][2] + v[1][3]);
    t += __shfl_xor(t, 16); t += __shfl_xor(t, 32); return __builtin_amdgcn_rsqf(t * (1.0f / 1024.0f) + RMS_EPS); }

struct EpiUp {
    static constexpr bool PERM = true, AFTER_DRAIN = false;
    bf16_t* O;
    __device__ __forceinline__ void operator()(const f32x4 (&acc)[2][2][4][2], const Unit& u, int wr, int wc, int fr, int fq) const {
        const int row0 = u.pm * BM + wr * 64 + fr, col0 = u.pn * BM + wc * 32 + 8 * fq;
#pragma unroll
        for (int ai = 0; ai < 2; ++ai)
#pragma unroll
            for (int m = 0; m < 4; ++m) { const int row = row0 + ai * HALF + m * 16;
                bf16_t* rowp = O + ((size_t)(row >> 8) * 64 + (col0 >> 6)) * 16384 + (size_t)(row & 255) * 64 + (col0 & 63);
#pragma unroll
                for (int bj = 0; bj < 2; ++bj) { f32x4 v0 = acc[ai][bj][m][0], v1 = acc[ai][bj][m][1];
#pragma unroll
                    for (int e = 0; e < 4; ++e) { const float a0 = fmaxf(v0[e], 0.f), a1 = fmaxf(v1[e], 0.f); v0[e] = a0 * a0; v1[e] = a1 * a1; }
                    *(u32x4*)(rowp + bj * 2 * 16384) = pack8(v0, v1); } }
    }
};
template <int NQ> struct EpiRes {
    static constexpr bool PERM = true, AFTER_DRAIN = false;
    const bf16_t* base; bf16_t* hb; float* ssout; const float* ss;
    __device__ __forceinline__ void operator()(const f32x4 (&acc)[2][2][4][2], const Unit& u, int wr, int wc, int fr, int fq) const {
        const int row0 = u.pm * BM + wr * 64 + fr, col0 = u.pn * BM + wc * 32 + 8 * fq;
#pragma unroll
        for (int ai = 0; ai < 2; ++ai) {
            u32x4 bw[4][2]; f32x4 sv[4][2];
#pragma unroll
            for (int m = 0; m < 4; ++m) { if (NQ > 0) slots_issue<NQ == 8 ? 8 : 4>(ss, row0 + ai * HALF + m * 16, fq, sv[m]);
#pragma unroll
                for (int bj = 0; bj < 2; ++bj) bw[m][bj] = *(const u32x4*)(base + (size_t)(row0 + ai * HALF + m * 16) * 1024 + col0 + bj * HALF); }
#pragma unroll
            for (int m = 0; m < 4; ++m) { const int row = row0 + ai * HALF + m * 16; const size_t off = (size_t)row * 1024 + col0; float s = 0.f;
                float sc = 1.f; if (NQ > 0) { const float r = slots_rstd<NQ == 8 ? 8 : 4>(sv[m]); sc = r * r; }
#pragma unroll
                for (int bj = 0; bj < 2; ++bj) { f32x4 b0, b1; unpack8(bw[m][bj], b0, b1);
                    const u32x4 w = pack8(b0 + acc[ai][bj][m][0] * sc, b1 + acc[ai][bj][m][1] * sc);
                    *(u32x4*)(hb + off + bj * HALF) = w; s += (sumsq_pk(w.x) + sumsq_pk(w.y)) + (sumsq_pk(w.z) + sumsq_pk(w.w)); }
                s += __shfl_xor(s, 16); s += __shfl_xor(s, 32);
                if (fq == 0) ssout[(size_t)row * 32 + 4 * u.pn + wc] = s; }
            asm volatile("" ::: "memory"); }
    }
};
struct EpiGlu {
    static constexpr bool PERM = true, AFTER_DRAIN = false;
    const bf16_t* base; bf16_t* hb; float* ssout;
    __device__ __forceinline__ void operator()(const f32x4 (&acc)[2][2][4][2], const Unit& u, int wr, int wc, int fr, int fq) const {
        const int row0 = u.pm * BM + wr * 64 + fr, ch0 = u.pn * 128 + wc * 16 + 4 * fq;
#pragma unroll
        for (int ai = 0; ai < 2; ++ai) {
            u32x2 bw[4][2];
#pragma unroll
            for (int m = 0; m < 4; ++m)
#pragma unroll
                for (int bj = 0; bj < 2; ++bj) bw[m][bj] = *(const u32x2*)(base + (size_t)(row0 + ai * HALF + m * 16) * 1024 + ch0 + bj * 64);
#pragma unroll
            for (int m = 0; m < 4; ++m) { const int row = row0 + ai * HALF + m * 16; const size_t off = (size_t)row * 1024 + ch0; float s = 0.f;
#pragma unroll
                for (int bj = 0; bj < 2; ++bj) { const f32x4 av = acc[ai][bj][m][0], bv = acc[ai][bj][m][1];
                    const float h0 = bflo(bw[m][bj].x) + av[0] * sigmoidf_(bv[0]), h1 = bfhi(bw[m][bj].x) + av[1] * sigmoidf_(bv[1]), h2 = bflo(bw[m][bj].y) + av[2] * sigmoidf_(bv[2]), h3 = bfhi(bw[m][bj].y) + av[3] * sigmoidf_(bv[3]);
                    u32x2 w; w.x = cvt_pk_bf16(h0, h1); w.y = cvt_pk_bf16(h2, h3); *(u32x2*)(hb + off + bj * 64) = w; s += sumsq_pk(w.x) + sumsq_pk(w.y); }
                s += __shfl_xor(s, 16); s += __shfl_xor(s, 32);
                if (fq == 0) ssout[(size_t)row * 32 + 4 * u.pn + wc] = s; }
            asm volatile("" ::: "memory"); }
    }
};
struct EpiPP {
    static constexpr bool PERM = true, AFTER_DRAIN = false;
    bf16_t* pp;
    __device__ __forceinline__ void operator()(const f32x4 (&acc)[2][2][4][2], const Unit& u, int wr, int wc, int fr, int fq) const {
        const int row0 = u.pm * BM + wr * 64 + fr, col0 = u.pn * BM + wc * 32 + 8 * fq;
#pragma unroll
        for (int ai = 0; ai < 2; ++ai)
#pragma unroll
            for (int m = 0; m < 4; ++m) { const size_t off = (size_t)(row0 + ai * HALF + m * 16) * 1024 + col0;
#pragma unroll
                for (int bj = 0; bj < 2; ++bj) *(u32x4*)(pp + off + bj * HALF) = pack8(acc[ai][bj][m][0], acc[ai][bj][m][1]);
                asm volatile("" ::: "memory"); }
    }
};
struct EpiGate {
    static constexpr bool PERM = true, AFTER_DRAIN = false;
    const bf16_t* base; bf16_t* hb; float* ssout; const float* ss; const bf16_t* pp;
    __device__ __forceinline__ void operator()(const f32x4 (&acc)[2][2][4][2], const Unit& u, int wr, int wc, int fr, int fq) const {
        const int row0 = u.pm * BM + wr * 64 + fr, col0 = u.pn * BM + wc * 32 + 8 * fq;
#pragma unroll
        for (int ai = 0; ai < 2; ++ai)
#pragma unroll
            for (int mh = 0; mh < 2; ++mh) {
                u32x4 bw[2][2], pw[2][2]; f32x4 sv[2][2];
#pragma unroll
                for (int mm = 0; mm < 2; ++mm) { const int row = row0 + ai * HALF + (2 * mh + mm) * 16; slots_issue<4>(ss, row, fq, sv[mm]);
#pragma unroll
                    for (int bj = 0; bj < 2; ++bj) { bw[mm][bj] = *(const u32x4*)(base + (size_t)row * 1024 + col0 + bj * HALF); pw[mm][bj] = *(const u32x4*)(pp + (size_t)row * 1024 + col0 + bj * HALF); } }
#pragma unroll
                for (int mm = 0; mm < 2; ++mm) { const int m = 2 * mh + mm, row = row0 + ai * HALF + m * 16; const size_t off = (size_t)row * 1024 + col0; float s = 0.f; const float rs = slots_rstd<4>(sv[mm]);
#pragma unroll
                    for (int bj = 0; bj < 2; ++bj) { f32x4 b0, b1, p0, p1; unpack8(bw[mm][bj], b0, b1); unpack8(pw[mm][bj], p0, p1);
#pragma unroll
                        for (int e = 0; e < 4; ++e) { b0[e] += sigmoidf_(acc[ai][bj][m][0][e] * rs) * p0[e]; b1[e] += sigmoidf_(acc[ai][bj][m][1][e] * rs) * p1[e]; }
                        const u32x4 w = pack8(b0, b1);
                        *(u32x4*)(hb + off + bj * HALF) = w; s += (sumsq_pk(w.x) + sumsq_pk(w.y)) + (sumsq_pk(w.z) + sumsq_pk(w.w)); }
                    s += __shfl_xor(s, 16); s += __shfl_xor(s, 32);
                    if (fq == 0) ssout[(size_t)row * 32 + 4 * u.pn + wc] = s; }
                asm volatile("" ::: "memory"); }
    }
};
struct EpiQKV {
    static constexpr bool PERM = true, AFTER_DRAIN = false;
    bf16_t* Qo; bf16_t* Ko; bf16_t* Vto; const float* ss; const float* ropeC; const float* ropeS;
    __device__ __forceinline__ void operator()(const f32x4 (&acc)[2][2][4][2], const Unit& u, int wr, int wc, int fr, int fq) const {
        const int row0 = u.pm * BM + wr * 64 + fr, cl0 = wc * 32 + 8 * fq;
        const int kind = u.pn < 4 ? 0 : (u.pn == 4 ? 1 : 2);
        const bool rot_wave = ((wc & 1) == 0) && kind != 2; const bool rot_lane = rot_wave && fq < 2; const float sgn = fq == 0 ? -1.f : 1.f;
#pragma unroll
        for (int ai = 0; ai < 2; ++ai) {
            f32x4 sv[4][2];
#pragma unroll
            for (int m = 0; m < 4; ++m) slots_issue<4>(ss, row0 + ai * HALF + m * 16, fq, sv[m]);
#pragma unroll
            for (int m = 0; m < 4; ++m) { const int row = row0 + ai * HALF + m * 16; const float rs = slots_rstd<4>(sv[m]); const int pos = row & 16383;
                f32x4 c0 = {1.f, 1.f, 1.f, 1.f}, c1 = c0, s0 = {0.f, 0.f, 0.f, 0.f}, s1 = s0;
                if (rot_lane) { c0 = *(const f32x4*)(ropeC + pos * 8); c1 = *(const f32x4*)(ropeC + pos * 8 + 4); s0 = *(const f32x4*)(ropeS + pos * 8) * sgn; s1 = *(const f32x4*)(ropeS + pos * 8 + 4) * sgn; }
#pragma unroll
                for (int bj = 0; bj < 2; ++bj) { f32x4 v0 = acc[ai][bj][m][0] * rs, v1 = acc[ai][bj][m][1] * rs;
                    if (rot_wave) { f32x4 q0, q1;
#pragma unroll
                        for (int e = 0; e < 4; ++e) { q0[e] = __shfl_xor(v0[e], 16); q1[e] = __shfl_xor(v1[e], 16); }
                        v0 = v0 * c0 + q0 * s0; v1 = v1 * c1 + q1 * s1; }
                    const int col = u.pn * BM + bj * HALF + cl0;
                    if (kind == 0) *(u32x4*)(Qo + (size_t)row * 1024 + col) = pack8(v0, v1);
                    else if (kind == 1) *(u32x4*)(Ko + (size_t)row * 256 + (col - 1024)) = pack8(v0, v1);
                    else { const int cv = col - 1280, kh = cv >> 6, d0 = cv & 63, b = row >> 14; bf16_t* vp = Vto + ((size_t)((b * 4 + kh) * 64 + d0) * 16384 + pos); const u32x4 w = pack8(v0, v1);
                        vp[0] = (bf16_t)(w.x & 0xffff); vp[16384] = (bf16_t)(w.x >> 16); vp[2 * 16384] = (bf16_t)(w.y & 0xffff); vp[3 * 16384] = (bf16_t)(w.y >> 16);
                        vp[4 * 16384] = (bf16_t)(w.z & 0xffff); vp[5 * 16384] = (bf16_t)(w.z >> 16); vp[6 * 16384] = (bf16_t)(w.w & 0xffff); vp[7 * 16384] = (bf16_t)(w.w >> 16); } } asm volatile("" ::: "memory"); } }
    }
};
template <class Epi, class Sched, bool ALIGN_EPI = false, bool SP2 = false, bool A_BLK = false  >
__device__ __forceinline__ void gemm_phase(PG8_LAS unsigned char* lds, const Gemm g, const Sched& S, const Epi& E) {
    int tid_ = threadIdx.x; asm volatile("" : "+v"(tid_));
    const int tid = tid_, wid = __builtin_amdgcn_readfirstlane(tid >> 6), lane = tid & 63, wr = wid >> 2, wc = wid & 3, fr = lane & 15, fq = lane >> 4;
    int Kq = g.K; asm volatile("" : "+s"(Kq)); const int K = Kq, nt = K / BK;
    unsigned voffA[2], voffB[2];
#pragma unroll
    for (int i = 0; i < 2; ++i) { int R, C; stage_rc(tid * 16 + i * 8192, R, C); const int Rb = Epi::PERM ? ((R & ~31) + perm32(R & 31)) : R;
        voffA[i] = A_BLK ? (unsigned)(R * 64 + C) * 2u : (unsigned)(R * K + C) * 2u; voffB[i] = (unsigned)(Rb * 64 + C) * 2u;     }
    const size_t kstep = (size_t)(BK * 2);
    const size_t hstep = (size_t)HALF * K * 2;
    const size_t tstep = 2 * hstep;
    const size_t kstepB = 32768, hstepB = 16384, tstepB = (size_t)(K / 64) * 32768;
    const size_t kstepA = A_BLK ? (size_t)32768 : kstep, hstepA = A_BLK ? (size_t)16384 : hstep, tstepA = A_BLK ? (size_t)(K / 64) * 32768 : tstep;
    const unsigned ldsw = (unsigned)wid * 1024u;
    const int aoff = lds_byte(wr * 64 + fr, fq * 8), boff = lds_byte(wc * 32 + fr, fq * 8);
#define PG8_SA(b, h) (((b) * 2 + (h)) * HTB)
#define PG8_SB(b, h) ((4 + (b) * 2 + (h)) * HTB)
#define PG8_STAGE(bufoff, gbase, voff) do { _Pragma("unroll") for (int _i = 0; _i < 2; ++_i) \
        __builtin_amdgcn_global_load_lds((const unsigned*)((const char*)(gbase) + (voff)[_i]), (PG8_LAS unsigned*)(lds + (bufoff) + ldsw + _i * 8192), 16, 0, 0); } while (0)
#define PG8_LDA(dst, b, h) do { _Pragma("unroll") for (int m = 0; m < 4; ++m) _Pragma("unroll") for (int k = 0; k < 2; ++k) dst[m][k] = *(const PG8_LAS bf16x8*)(lds + PG8_SA(b, h) + aoff + m * 2048 + k * 1024); } while (0)
#define PG8_LDB(dst, b, h) do { _Pragma("unroll") for (int n = 0; n < 2; ++n) _Pragma("unroll") for (int k = 0; k < 2; ++k) dst[n][k] = *(const PG8_LAS bf16x8*)(lds + PG8_SB(b, h) + boff + n * 2048 + k * 1024); } while (0)
#define PG8_MMA(ai, bj, At, Bt) do { __builtin_amdgcn_s_setprio(1); _Pragma("unroll") for (int m = 0; m < 4; ++m) _Pragma("unroll") for (int n = 0; n < 2; ++n) _Pragma("unroll") for (int k = 0; k < 2; ++k) \
        acc[ai][bj][m][n] = __builtin_amdgcn_mfma_f32_16x16x32_bf16(Bt[n][k], At[m][k], acc[ai][bj][m][n], 0, 0, 0); __builtin_amdgcn_s_setprio(0); } while (0)
#define PG8_WAIT_V(n) asm volatile("s_waitcnt vmcnt(" #n ")" ::: "memory")
#define PG8_WAIT_L(n) asm volatile("s_waitcnt lgkmcnt(" #n ")" ::: "memory")
#define PG8_BAR __builtin_amdgcn_s_barrier()
#define PG8_SCHED __builtin_amdgcn_sched_barrier(0)
    Unit cur, nxt; int ui = 0;
    if (!S.next(0, cur)) return;
    f32x4 acc[2][2][4][2];
#pragma unroll
    for (int a = 0; a < 2; ++a)
#pragma unroll
        for (int b = 0; b < 2; ++b)
#pragma unroll
            for (int m = 0; m < 4; ++m)
#pragma unroll
                for (int n = 0; n < 2; ++n) acc[a][b][m][n] = (f32x4){0.f, 0.f, 0.f, 0.f};
    bf16x8 At[4][2], B0[2][2], B1[2][2];
    const char* cA = (const char*)g.A + (size_t)cur.pm * tstepA; const char* cB = (const char*)g.Bt + (size_t)cur.pn * tstepB;
    S.a_ready(cur);
    if constexpr (SP2) {
        PG8_STAGE(PG8_SB(0, 0), cB, voffB); PG8_STAGE(PG8_SB(0, 1), cB + hstepB, voffB); PG8_STAGE(PG8_SA(0, 0), cA, voffA); PG8_STAGE(PG8_SA(0, 1), cA + hstepA, voffA);
        if (wr == 1) PG8_BAR;
        PG8_WAIT_V(2); PG8_BAR;
        PG8_STAGE(PG8_SB(1, 0), cB + kstepB, voffB); PG8_STAGE(PG8_SA(1, 0), cA + kstepA, voffA); PG8_STAGE(PG8_SB(1, 1), cB + hstepB + kstepB, voffB);
        PG8_WAIT_V(6); PG8_BAR;
    } else {
        PG8_STAGE(PG8_SB(0, 0), cB, voffB); PG8_STAGE(PG8_SA(0, 0), cA, voffA); PG8_STAGE(PG8_SB(0, 1), cB + hstepB, voffB); PG8_STAGE(PG8_SA(0, 1), cA + hstepA, voffA);
        if (wr == 1) PG8_BAR;
        PG8_WAIT_V(4); PG8_BAR;
        PG8_STAGE(PG8_SB(1, 0), cB + kstepB, voffB); PG8_STAGE(PG8_SA(1, 0), cA + kstepA, voffA); PG8_STAGE(PG8_SB(1, 1), cB + hstepB + kstepB, voffB);
        PG8_WAIT_V(6); PG8_BAR;
    }
    for (;;) {
        const bool has_next = S.next(ui + 1, nxt);
        const char* nA = has_next ? (const char*)g.A + (size_t)nxt.pm * tstepA : cA; const char* nB = has_next ? (const char*)g.Bt + (size_t)nxt.pn * tstepB : cB;
        for (int t = 0; t < nt; t += 2) {
            const bool last = (t == nt - 2);
            const char* a1 = cA + (size_t)(t + 1) * kstepA;
            const char* a2 = last ? nA : cA + (size_t)(t + 2) * kstepA; const char* b2 = last ? nB : cB + (size_t)(t + 2) * kstepB;
            const char* a3 = a2 + kstepA; const char* b3 = b2 + kstepB;
            if (last && has_next) S.a_ready(nxt);
            if constexpr (SP2) {
            PG8_LDB(B0, 0, 0); PG8_LDB(B1, 0, 1); PG8_SCHED; PG8_LDA(At, 0, 0); PG8_STAGE(PG8_SA(1, 1), a1 + hstepA, voffA);
            PG8_WAIT_V(8); PG8_WAIT_L(0); PG8_BAR; PG8_MMA(0, 0, At, B0); PG8_MMA(0, 1, At, B1); PG8_BAR; PG8_SCHED;
            PG8_LDA(At, 0, 1); PG8_STAGE(PG8_SB(0, 0), b2, voffB); PG8_STAGE(PG8_SB(0, 1), b2 + hstepB, voffB); PG8_STAGE(PG8_SA(0, 0), a2, voffA);
            PG8_WAIT_V(8); PG8_WAIT_L(0); PG8_BAR; PG8_MMA(1, 0, At, B0); PG8_MMA(1, 1, At, B1); PG8_BAR; PG8_SCHED;
            PG8_LDB(B0, 1, 0); PG8_LDB(B1, 1, 1); PG8_SCHED; PG8_LDA(At, 1, 0); PG8_STAGE(PG8_SA(0, 1), a2 + hstepA, voffA);
            PG8_WAIT_V(8); PG8_WAIT_L(0); PG8_BAR; PG8_MMA(0, 0, At, B0); PG8_MMA(0, 1, At, B1); PG8_BAR; PG8_SCHED;
            PG8_LDA(At, 1, 1); PG8_STAGE(PG8_SB(1, 0), b3, voffB); PG8_STAGE(PG8_SB(1, 1), b3 + hstepB, voffB); PG8_STAGE(PG8_SA(1, 0), a3, voffA);
            PG8_WAIT_V(8); PG8_WAIT_L(0); PG8_BAR; PG8_MMA(1, 0, At, B0); PG8_MMA(1, 1, At, B1); PG8_BAR; PG8_SCHED;
            } else {
            PG8_LDB(B0, 0, 0); PG8_SCHED; PG8_LDA(At, 0, 0); PG8_STAGE(PG8_SA(1, 1), a1 + hstepA, voffA);
            PG8_WAIT_L(8); PG8_BAR; PG8_WAIT_L(0); PG8_MMA(0, 0, At, B0); PG8_BAR; PG8_SCHED;
            PG8_LDB(B1, 0, 1); PG8_STAGE(PG8_SB(0, 0), b2, voffB);
            PG8_BAR; PG8_WAIT_L(0); PG8_MMA(0, 1, At, B1); PG8_BAR;
            PG8_LDA(At, 0, 1); PG8_STAGE(PG8_SA(0, 0), a2, voffA);
            PG8_BAR; PG8_WAIT_L(0); PG8_MMA(1, 0, At, B0); PG8_BAR; PG8_SCHED;
            PG8_STAGE(PG8_SB(0, 1), b2 + hstepB, voffB);
            PG8_WAIT_V(6); PG8_BAR; PG8_MMA(1, 1, At, B1); PG8_BAR;
            PG8_LDB(B0, 1, 0); PG8_SCHED; PG8_LDA(At, 1, 0); PG8_STAGE(PG8_SA(0, 1), a2 + hstepA, voffA);
            PG8_WAIT_L(8); PG8_BAR; PG8_WAIT_L(0); PG8_MMA(0, 0, At, B0); PG8_BAR; PG8_SCHED;
            PG8_LDB(B1, 1, 1); PG8_STAGE(PG8_SB(1, 0), b3, voffB);
            PG8_BAR; PG8_WAIT_L(0); PG8_MMA(0, 1, At, B1); PG8_BAR;
            PG8_LDA(At, 1, 1); PG8_STAGE(PG8_SA(1, 0), a3, voffA);
            PG8_BAR; PG8_WAIT_L(0); PG8_MMA(1, 0, At, B0); PG8_BAR; PG8_SCHED;
            PG8_STAGE(PG8_SB(1, 1), b3 + hstepB, voffB);
            PG8_WAIT_V(6); PG8_BAR; PG8_MMA(1, 1, At, B1); PG8_BAR;
            }
        }
        if constexpr (ALIGN_EPI) { if (wr == 0) PG8_BAR; }
        if constexpr (!Epi::AFTER_DRAIN) { E(acc, cur, wr, wc, fr, fq); S.done(cur); }
        if (!has_next) break;
#pragma unroll
        for (int a = 0; a < 2; ++a)
#pragma unroll
            for (int b = 0; b < 2; ++b)
#pragma unroll
                for (int m = 0; m < 4; ++m)
#pragma unroll
                    for (int n = 0; n < 2; ++n) acc[a][b][m][n] = (f32x4){0.f, 0.f, 0.f, 0.f};
        cur = nxt; cA = nA; cB = nB; ++ui;
        if constexpr (ALIGN_EPI) { if (wr == 1) PG8_BAR; }
    }
    PG8_WAIT_V(0);
    if constexpr (!ALIGN_EPI) { if (wr == 0) PG8_BAR; }
    PG8_BAR;
    if constexpr (Epi::AFTER_DRAIN) { E.fused(acc, cur, wr, wc, fr, fq, lds, wid, lane); S.done(cur); }
#undef PG8_SA
#undef PG8_SB
#undef PG8_STAGE
#undef PG8_LDA
#undef PG8_LDB
#undef PG8_MMA
#undef PG8_WAIT_V
#undef PG8_WAIT_L
#undef PG8_BAR
#undef PG8_SCHED
}
}
#define LAS __attribute__((address_space(3)))
typedef unsigned short bf16;
typedef unsigned v4u __attribute__((ext_vector_type(4)));
typedef unsigned v2u __attribute__((ext_vector_type(2)));
typedef float f32x4 __attribute__((ext_vector_type(4)));
typedef float f32x2 __attribute__((ext_vector_type(2)));
typedef float f32x16 __attribute__((ext_vector_type(16)));
typedef short bf16x8 __attribute__((ext_vector_type(8)));
constexpr int SEQ = 16384, NB = 2, MT = NB * SEQ, DM = 1024, FF = 4096, PLE = 256;
constexpr size_t MiB = 1u << 20;
constexpr size_t WS_CTL = 0;
constexpr size_t WS_SS = 465 * MiB;
constexpr size_t WS_ROPE = 3 * MiB;
constexpr size_t WS_S5T = 4 * MiB;
constexpr size_t WS_WGLU = 6 * MiB, WS_WUP = 14 * MiB, WS_WDOWN = 46 * MiB, WS_WGATE = 78 * MiB, WS_WPROJ = 86 * MiB, WS_WQKV2 = 88 * MiB, WS_WQ3 = 91 * MiB, WS_WO = 93 * MiB;
constexpr size_t WS_PB = 97 * MiB, WS_K = 113 * MiB, WS_VT = 129 * MiB, WS_HB = 145 * MiB, WS_ACT = 209 * MiB, WS_END = 481 * MiB;
constexpr size_t ACT_Y = 0, ACT_Q = 0, ACT_O = 64 * MiB, ACT_PP = 0, ACT_HB2 = 128 * MiB, ACT_ST = 192 * MiB;
constexpr int LDS_BYTES = 147456, NPHASE = 28;
constexpr float C2 = 0.125f * 1.4426950408889634f;

__device__ __forceinline__ int tid_opq() { int t = threadIdx.x; asm volatile("" : "+v"(t)); return t; }
__device__ __forceinline__ int bid_opq() { int t = blockIdx.x; asm volatile("" : "+s"(t)); return t; }
#define LDS_WAIT() asm volatile("s_waitcnt lgkmcnt(0)" ::: "memory")
__device__ __forceinline__ unsigned f2bf(float f) { unsigned u = __builtin_bit_cast(unsigned, f); return (u + 0x7fffu + ((u >> 16) & 1u)) >> 16; }
__device__ __forceinline__ unsigned pk2(float lo, float hi) { return f2bf(lo) | (f2bf(hi) << 16); }
__device__ __forceinline__ float wave_sum(float v) {
#pragma unroll
    for (int o = 1; o < 64; o <<= 1) v += __shfl_xor(v, o);
    return v;
}
__device__ __forceinline__ void sincos_d(double x, float& s, float& c) {
    const double k = __builtin_rint(x * 0.63661977236758134308);
    double r = __builtin_fma(-k, 1.57079632679489655800e+00, x); r = __builtin_fma(-k, 6.12323399573676603587e-17, r);
    const double r2 = r * r;
    double sp = -2.50521083854417187751e-08; sp = sp * r2 + 2.75573192239858906526e-06; sp = sp * r2 - 1.98412698412698412698e-04; sp = sp * r2 + 8.33333333333333333333e-03; sp = sp * r2 - 1.66666666666666666667e-01;
    const double sv = r + r * r2 * sp;
    double cp = 2.08767569878680989792e-09; cp = cp * r2 - 2.75573192239858906526e-07; cp = cp * r2 + 2.48015873015873015873e-05; cp = cp * r2 - 1.38888888888888888889e-03; cp = cp * r2 + 4.16666666666666666667e-02; cp = cp * r2 - 0.5;
    const double cv = 1.0 + r2 * cp;
    const int q = ((int)(long long)k) & 3;
    const double so = (q & 1) ? cv : sv, co = (q & 1) ? sv : cv;
    s = (float)((q & 2) ? -so : so); c = (float)(((q + 1) & 2) ? -co : co);
}

__device__ __forceinline__ void tr_item(const float* W, int K, int N, bf16* WT, int row_off, const float* gain, float scale, int mode, LAS float* scr, int item, int lane) {
    const int nblk = N / 64, kb = item / nblk, nb = item % nblk, k0 = 32 * kb, n0 = 64 * nb;
    const int kk = lane >> 4, n4 = lane & 15;
#pragma unroll
    for (int i = 0; i < 8; ++i) { const int k = 4 * i + kk; const float gs = gain ? gain[k0 + k] * scale : scale;
        *(LAS f32x4*)(scr + k * 68 + 4 * n4) = *(const f32x4*)(W + (size_t)(k0 + k) * N + n0 + 4 * n4) * gs; }
    LDS_WAIT();
    const int c = lane & 3;
#pragma unroll
    for (int jj = 0; jj < 4; ++jj) { const int n = (lane >> 2) + 16 * jj; const LAS float* s = scr + (8 * c) * 68 + n;
        v4u o; o.x = pk2(s[0 * 68], s[1 * 68]); o.y = pk2(s[2 * 68], s[3 * 68]); o.z = pk2(s[4 * 68], s[5 * 68]); o.w = pk2(s[6 * 68], s[7 * 68]);
        const int nn = n0 + n; const int orow = mode == 0 ? row_off + nn : (nn < 1024 ? 8 * (nn >> 2) + (nn & 3) : 8 * ((nn - 1024) >> 2) + 4 + (nn & 3));
        *(v4u*)(WT + ((size_t)(orow >> 8) * (K >> 6) + (k0 >> 6)) * 16384 + (size_t)(orow & 255) * 64 + (k0 & 63) + 8 * c) = o; }
    LDS_WAIT();
}

struct Args { const float* in[25]; float* out; unsigned char* ws; double inv[8]; int ph_lo, ph_hi, grid, pad; };
static_assert(sizeof(Args) == 25 * 8 + 8 + 8 + 64 + 16, "Args has no padding");
#define GAS __attribute__((address_space(1)))
struct ArgsK { const GAS float* in[25]; GAS float* out; GAS unsigned char* ws; double inv[8]; int ph_lo, ph_hi, grid, pad; };
static_assert(sizeof(ArgsK) == sizeof(Args), "ArgsK mirrors Args");
typedef const __attribute__((address_space(4))) ArgsK* kap_t;
__device__ __forceinline__ kap_t kargs() { unsigned long long p = (unsigned long long)__builtin_amdgcn_kernarg_segment_ptr(); asm volatile("" : "+s"(p)); return (kap_t)p; }
#define KIN(k) ((const float*)ap->in[k])

__device__ __forceinline__ void phase0(kap_t ap, LAS unsigned char* lds, int G) {
    const int tid = tid_opq(), lane = tid & 63, wave = __builtin_amdgcn_readfirstlane(tid >> 6);
    unsigned char* ws = (unsigned char*)ap->ws;
    LAS float* scr = (LAS float*)(lds + wave * 16384);
    const int gw = bid_opq() * 8 + wave, NGW = G * 8;
    const float* norm_mix = KIN(2); const float* kv_norm = KIN(12); const float* norm_mlp = KIN(18); const float* norm_ple = KIN(21);
    constexpr int I_GLU = 32 * 32, I_UP = 32 * 64, I_DOWN = 128 * 16, I_SQ = 32 * 16, I_PROJ = 8 * 16, I_KV = 32 * 4;
    constexpr int NITEMS = 2 * I_GLU + 4 * I_UP + 4 * I_DOWN + 4 * I_SQ + 4 * I_PROJ + I_SQ + 2 * I_KV + I_SQ + 2 * I_SQ;
    for (int it = gw; it < NITEMS; it += NGW) {
        int r = it;
        if (r < 2 * I_GLU) { const int l = r / I_GLU; tr_item(KIN(11) + (size_t)l * DM * 2048, DM, 2048, (bf16*)(ws + WS_WGLU) + (size_t)l * 2048 * DM, 0, nullptr, 1.f, 1, scr, r % I_GLU, lane); continue; } r -= 2 * I_GLU;
        if (r < 4 * I_UP) { const int l = r / I_UP; tr_item(KIN(19) + (size_t)l * DM * FF, DM, FF, (bf16*)(ws + WS_WUP) + (size_t)l * FF * DM, 0, norm_mlp + l * DM, 1.f, 0, scr, r % I_UP, lane); continue; } r -= 4 * I_UP;
        if (r < 4 * I_DOWN) { const int l = r / I_DOWN; tr_item(KIN(20) + (size_t)l * FF * DM, FF, DM, (bf16*)(ws + WS_WDOWN) + (size_t)l * DM * FF, 0, nullptr, 1.f, 0, scr, r % I_DOWN, lane); continue; } r -= 4 * I_DOWN;
        if (r < 4 * I_SQ) { const int l = r / I_SQ; tr_item(KIN(22) + (size_t)l * DM * DM, DM, DM, (bf16*)(ws + WS_WGATE) + (size_t)l * DM * DM, 0, norm_ple + l * DM, 1.f, 0, scr, r % I_SQ, lane); continue; } r -= 4 * I_SQ;
        if (r < 4 * I_PROJ) { const int l = r / I_PROJ; tr_item(KIN(23) + (size_t)l * PLE * DM, PLE, DM, (bf16*)(ws + WS_WPROJ) + (size_t)l * DM * PLE, 0, nullptr, 1.f, 0, scr, r % I_PROJ, lane); continue; } r -= 4 * I_PROJ;
        if (r < I_SQ) { tr_item(KIN(15), DM, DM, (bf16*)(ws + WS_WQKV2), 0, norm_mix + 2 * DM, C2, 0, scr, r, lane); continue; } r -= I_SQ;
        if (r < I_KV) { tr_item(KIN(13), DM, 256, (bf16*)(ws + WS_WQKV2), 1024, kv_norm, 1.f, 0, scr, r, lane); continue; } r -= I_KV;
        if (r < I_KV) { tr_item(KIN(14), DM, 256, (bf16*)(ws + WS_WQKV2), 1280, kv_norm, 1.f, 0, scr, r, lane); continue; } r -= I_KV;
        if (r < I_SQ) { tr_item(KIN(15) + (size_t)DM * DM, DM, DM, (bf16*)(ws + WS_WQ3), 0, norm_mix + 3 * DM, C2, 0, scr, r, lane); continue; } r -= I_SQ;
        { const int l = r / I_SQ; tr_item(KIN(17) + (size_t)l * DM * DM, DM, DM, (bf16*)(ws + WS_WO) + (size_t)l * DM * DM, 0, nullptr, 1.f, 0, scr, r % I_SQ, lane); }
    }
    const int gt = bid_opq() * 512 + tid, NGT = G * 512;
    { float* rc = (float*)(ws + WS_ROPE); float* rsn = rc + SEQ * 8;
      for (int i = gt; i < SEQ * 8; i += NGT) { float s, c; sincos_d((double)(i >> 3) * ap->inv[i & 7], s, c); rc[i] = c; rsn[i] = s; } }
    for (int i = gt; i < 2 * 64 * 64; i += NGT) {
        const int l = i >> 12, g = (i >> 6) & 63, n = i & 63;
        unsigned char* tb = ws + WS_S5T + (size_t)l * MiB;
        bf16* BBt = (bf16*)tb; bf16* Cc = (bf16*)(tb + 256 * 1024); float* At = (float*)(tb + 512 * 1024); float* A64 = (float*)(tb + 576 * 1024);
        const double dt = exp((double)KIN(5)[l * 64 + g]);
        const double lr = (double)KIN(3)[i], li = (double)KIN(4)[i];
        const double mag = exp(lr * dt); float sf, cf; sincos_d(li * dt, sf, cf);
        double sd, cd; {
            sd = (double)sf; cd = (double)cf; }
        const double ar = mag * cd, ai = mag * sd, den = lr * lr + li * li, nr = ar - 1.0;
        const double cr = (nr * lr + ai * li) / den, ci = (ai * lr - nr * li) / den;
        At[(g * 64 + n) * 2] = (float)ar; At[(g * 64 + n) * 2 + 1] = (float)ai;
        double pr = ar, pi = ai;
#pragma unroll 1
        for (int s = 0; s < 6; ++s) { const double tr = pr * pr - pi * pi, ti = 2.0 * pr * pi; pr = tr; pi = ti; }
        A64[(g * 64 + n) * 2] = (float)pr; A64[(g * 64 + n) * 2 + 1] = (float)pi;
        const float* bre = KIN(6) + (size_t)i * 16; const float* bim = KIN(7) + (size_t)i * 16; const float* gn = KIN(2) + l * DM + g * 16;
#pragma unroll 1
        for (int h = 0; h < 16; ++h) { const double br = bre[h], bi = bim[h], gg = gn[h];
            BBt[(((size_t)(g * 2 + 0) * 64 + n) * 16) + h] = (bf16)f2bf((float)((cr * br - ci * bi) * gg));
            BBt[(((size_t)(g * 2 + 1) * 64 + n) * 16) + h] = (bf16)f2bf((float)((cr * bi + ci * br) * gg));
            const size_t ci_ = ((size_t)(l * 64 + g) * 16 + h) * 64 + n;
            Cc[((size_t)(g * 16 + h)) * 128 + 2 * n] = (bf16)f2bf(KIN(8)[ci_]); Cc[((size_t)(g * 16 + h)) * 128 + 2 * n + 1] = (bf16)f2bf(-KIN(9)[ci_]); }
    }
    { float* ss = (float*)(ws + WS_SS); bf16* hb2 = (bf16*)(ws + WS_ACT + ACT_HB2);
      for (int m0 = 8 * gw; m0 < MT; m0 += 8 * NGW) {
          f32x4 v[8][4];
#pragma unroll
          for (int r = 0; r < 8; ++r)
#pragma unroll
              for (int j = 0; j < 4; ++j) v[r][j] = ((const f32x4*)(KIN(0) + (size_t)(m0 + r) * DM))[lane + 64 * j];
#pragma unroll
          for (int r = 0; r < 8; ++r) { float s = 0.f;
#pragma unroll
              for (int j = 0; j < 4; ++j) { s += pg8::sumsq4(v[r][j]); v2u w; w.x = pg8::cvt_pk_bf16(v[r][j][0], v[r][j][1]); w.y = pg8::cvt_pk_bf16(v[r][j][2], v[r][j][3]); ((v2u*)(hb2 + (size_t)(m0 + r) * DM))[lane + 64 * j] = w; }
              s = wave_sum(s); if (lane < 16) ss[(size_t)(m0 + r) * 32 + lane] = lane == 0 ? s : 0.f; } } }
}

__device__ __forceinline__ float gelu_tanh(float v) { const float z = v + 0.044715f * v * v * v; return v * __builtin_amdgcn_rcpf(1.0f + __builtin_amdgcn_exp2f(-2.0f * 0.7978845608028654f * pg8::LOG2E * z)); }
template <bool FINAL>
__device__ __forceinline__ void s5_pass(LAS unsigned char* lds, int G, const bf16* base, const float* ss, const unsigned char* tb, const float* gain, const float* dvec, float* St, bf16* Y) {
    const int tid = tid_opq(), lane = tid & 63, wave = __builtin_amdgcn_readfirstlane(tid >> 6), j = lane & 31, hi = lane >> 5;
    const bf16* BBt = (const bf16*)tb; const bf16* Cc = (const bf16*)(tb + 256 * 1024); const float* At = (const float*)(tb + 512 * 1024);
    LAS float* rs = (LAS float*)lds;
    LAS unsigned char* xb = lds + 1024 + wave * 8704;
    const f32x16 zero16 = {0.f, 0.f, 0.f, 0.f, 0.f, 0.f, 0.f, 0.f, 0.f, 0.f, 0.f, 0.f, 0.f, 0.f, 0.f, 0.f};
    const int tlA = 64 * ((j >> 2) & 1) + 4 * (j >> 3) + (j & 3);
    for (int unit = bid_opq(); unit < 256; unit += G) {
        const int b = unit >> 7, c128 = unit & 127, tok0 = b * SEQ + c128 * 128;
        __syncthreads();
        if (tid < 128) rs[tid] = pg8::rstd_of<4>(ss, tok0 + tid);
        __syncthreads();
#pragma unroll 1
        for (int gi = 0; gi < 8; ++gi) {
            const int g = wave + 8 * gi;
            const bf16* abase = base + (size_t)(tok0 + tlA) * DM + g * 16 + 8 * hi;
            v4u arow[4];
#pragma unroll
            for (int tt = 0; tt < 4; ++tt) arow[tt] = *(const v4u*)(abase + (size_t)(16 * tt) * DM);
            bf16x8 bop[2][2]; float ar[2], ai[2], nai[2], xr[2], xi[2];
#pragma unroll
            for (int st = 0; st < 2; ++st) {
#pragma unroll
                for (int c = 0; c < 2; ++c) bop[st][c] = *(const bf16x8*)(BBt + (((size_t)(g * 2 + c) * 64 + st * 32 + j) * 16 + 8 * hi));
                const f32x2 av = *(const f32x2*)(At + (g * 64 + st * 32 + j) * 2); ar[st] = av.x; ai[st] = av.y; nai[st] = -av.y;
                if (FINAL) { const f32x2 cv = *(const f32x2*)(St + (((size_t)(b * 256 + 2 * c128 + hi) * 64 + g) * 64 + st * 32 + j) * 2); xr[st] = cv.x; xi[st] = cv.y; } else { xr[st] = 0.f; xi[st] = 0.f; }
            }
            bf16x8 cop[4]; f32x4 gdv = {0.f, 0.f, 0.f, 0.f};
            const int ch = g * 16 + 4 * (lane >> 4);
            if (FINAL) {
#pragma unroll
                for (int ks = 0; ks < 4; ++ks) cop[ks] = *(const bf16x8*)(Cc + ((size_t)(g * 16 + (lane & 15)) * 128 + 32 * ks + 8 * (lane >> 4)));
                gdv = *(const f32x4*)(gain + ch) * *(const f32x4*)(dvec + ch);
            }
            v2u hvr[4][2];
            if (FINAL) {
#pragma unroll
                for (int tt = 0; tt < 4; ++tt)
#pragma unroll
                    for (int mt = 0; mt < 2; ++mt) hvr[tt][mt] = *(const v2u*)(base + (size_t)(tok0 + 64 * mt + 16 * tt + (lane & 15)) * DM + ch);
            }
#pragma unroll
            for (int tt = 0; tt < 4; ++tt) {
                const v4u a_cur = arow[tt];
                v2u hv[2]; if (FINAL) { hv[0] = hvr[tt][0]; hv[1] = hvr[tt][1]; }
                const float r = rs[tlA + 16 * tt];
                f32x4 u0, u1; pg8::unpack8(a_cur, u0, u1);
                const v4u aw = pg8::pack8(u0 * r, u1 * r); const bf16x8 aop = __builtin_bit_cast(bf16x8, aw);
                f32x16 acc[2][2];
#pragma unroll
                for (int st = 0; st < 2; ++st)
#pragma unroll
                    for (int c = 0; c < 2; ++c) acc[st][c] = __builtin_amdgcn_mfma_f32_32x32x16_bf16(aop, bop[st][c], zero16, 0, 0, 0);
                asm volatile("s_nop 15\n\ts_nop 15\n\ts_nop 15\n\ts_nop 15" : "+v"(acc[0][0]), "+v"(acc[0][1]), "+v"(acc[1][0]), "+v"(acc[1][1]));
#pragma unroll
                for (int q = 0; q < 16; ++q)
#pragma unroll
                    for (int st = 0; st < 2; ++st) {
                        float t0_, t1_, nr, ni;
                        asm("v_fma_f32 %0, %1, %2, %3" : "=v"(t0_) : "v"(nai[st]), "v"(xi[st]), "v"(acc[st][0][q]));
                        asm("v_fma_f32 %0, %1, %2, %3" : "=v"(nr) : "v"(ar[st]), "v"(xr[st]), "v"(t0_));
                        asm("v_fma_f32 %0, %1, %2, %3" : "=v"(t1_) : "v"(ai[st]), "v"(xr[st]), "v"(acc[st][1][q]));
                        asm("v_fma_f32 %0, %1, %2, %3" : "=v"(ni) : "v"(ar[st]), "v"(xi[st]), "v"(t1_));
                        xr[st] = nr; xi[st] = ni;
                        if (FINAL) *(LAS unsigned*)(xb + (16 * hi + q) * 272 + (st * 32 + j) * 4) = pg8::cvt_pk_bf16(nr, ni);
                    }
                if (FINAL) {
                    LDS_WAIT();
#pragma unroll
                    for (int mt = 0; mt < 2; ++mt) {
                        f32x4 d = {0.f, 0.f, 0.f, 0.f};
#pragma unroll
                        for (int ks = 0; ks < 4; ++ks) { const bf16x8 xop = *(const LAS bf16x8*)(xb + (16 * mt + (lane & 15)) * 272 + (32 * ks + 8 * (lane >> 4)) * 2); d = __builtin_amdgcn_mfma_f32_16x16x32_bf16(cop[ks], xop, d, 0, 0, 0); }
                        const int tl2 = 64 * mt + 16 * tt + (lane & 15);
                        const float r2 = rs[tl2];
                        f32x4 hvf; hvf[0] = pg8::bflo(hv[mt].x); hvf[1] = pg8::bfhi(hv[mt].x); hvf[2] = pg8::bflo(hv[mt].y); hvf[3] = pg8::bfhi(hv[mt].y);
                        f32x4 y = d + gdv * (hvf * r2);
#pragma unroll
                        for (int e = 0; e < 4; ++e) y[e] = gelu_tanh(y[e]);
                        v2u w; w.x = pg8::cvt_pk_bf16(y[0], y[1]); w.y = pg8::cvt_pk_bf16(y[2], y[3]);
                        *(v2u*)(Y + (size_t)(tok0 + tl2) * DM + ch) = w;
                    }
                    LDS_WAIT();
                }
            }
            if (!FINAL) {
#pragma unroll
                for (int st = 0; st < 2; ++st) { f32x2 o; o.x = xr[st]; o.y = xi[st]; *(f32x2*)(St + (((size_t)(b * 256 + 2 * c128 + hi) * 64 + g) * 64 + st * 32 + j) * 2) = o; }
            }
        }
    }
}
__device__ __forceinline__ void s5_carry(int G, const unsigned char* tb, float* St) {
    const int tid = tid_opq(), lane = tid & 63;
    if (tid >= 64) return;
    const float* A64 = (const float*)(tb + 576 * 1024);
    for (int bg = bid_opq(); bg < 128; bg += G) {
        const int b = bg >> 6, g = bg & 63;
        const f32x2 av = *(const f32x2*)(A64 + (g * 64 + lane) * 2);
        float cr = 0.f, ci = 0.f; const float nay = -av.y;
        float* p = St + (((size_t)(b * 256) * 64 + g) * 64 + lane) * 2;
#pragma unroll 1
        for (int k = 0; k < 256; k += 8) {
            f32x2 s[8];
#pragma unroll
            for (int u = 0; u < 8; ++u) s[u] = *(const f32x2*)(p + (size_t)(k + u) * 8192);
#pragma unroll
            for (int u = 0; u < 8; ++u) { f32x2 o; o.x = cr; o.y = ci; *(f32x2*)(p + (size_t)(k + u) * 8192) = o;
                float t0_, t1_, nr, ni;
                asm("v_fma_f32 %0, %1, %2, %3" : "=v"(t0_) : "v"(nay), "v"(ci), "v"(s[u].x));
                asm("v_fma_f32 %0, %1, %2, %3" : "=v"(nr) : "v"(av.x), "v"(cr), "v"(t0_));
                asm("v_fma_f32 %0, %1, %2, %3" : "=v"(t1_) : "v"(av.y), "v"(cr), "v"(s[u].y));
                asm("v_fma_f32 %0, %1, %2, %3" : "=v"(ni) : "v"(av.x), "v"(ci), "v"(t1_));
                cr = nr; ci = ni; }
        }
    }
}

__device__ __forceinline__ void attn_phase(LAS unsigned char* lds, int G, const bf16* Q, const bf16* Kb, const bf16* Vt, bf16* O, const float* sinks) {
    constexpr int KS = 144, VS = 528;
    const int tid = tid_opq(), lane = tid & 63, wave = __builtin_amdgcn_readfirstlane(tid >> 6), j = lane & 31, hi = lane >> 5;
    LAS unsigned char* Ksm = lds; LAS unsigned char* Vsm = lds + 256 * KS;
    const f32x16 zero16 = {0.f, 0.f, 0.f, 0.f, 0.f, 0.f, 0.f, 0.f, 0.f, 0.f, 0.f, 0.f, 0.f, 0.f, 0.f, 0.f};
    const int prow = 16 * ((j >> 2) & 1) + 4 * (j >> 3) + (j & 3);
    for (int unit = bid_opq(); unit < 1024; unit += G) {
        const int kh = unit & 3, nb = (unit >> 2) & 127, b = unit >> 9;
        __syncthreads();
#pragma unroll
        for (int it = 0; it < 4; ++it) { const int idx = tid + 512 * it, row = idx >> 3, ch = idx & 7, pos = nb * 128 - 128 + row;
            v4u v = {0u, 0u, 0u, 0u}; if (pos >= 0) v = *(const v4u*)(Kb + ((size_t)(b * SEQ + pos) * 256 + kh * 64 + ch * 8));
            *(LAS v4u*)(Ksm + row * KS + ch * 16) = v; }
#pragma unroll
        for (int it = 0; it < 4; ++it) { const int idx = tid + 512 * it, d = idx >> 5, ch = idx & 31, pos0 = nb * 128 - 128 + ch * 8;
            v4u v = {0u, 0u, 0u, 0u}; if (pos0 >= 0) v = *(const v4u*)(Vt + ((size_t)((b * 4 + kh) * 64 + d) * SEQ + pos0));
            *(LAS v4u*)(Vsm + d * VS + ch * 16) = v; }
        __syncthreads();
        const int hq = kh * 4 + (wave >> 1), qh = wave & 1;
        const float sink2 = sinks[hq] * pg8::LOG2E;
#pragma unroll 1
        for (int qt = 0; qt < 2; ++qt) {
            const int qi = 64 * qh + 32 * qt + j, kt0 = 2 * qh + qt;
            const size_t qrow = (size_t)(b * SEQ + nb * 128 + qi);
            bf16x8 qop[4];
#pragma unroll
            for (int ks = 0; ks < 4; ++ks) qop[ks] = *(const bf16x8*)(Q + qrow * DM + hq * 64 + 16 * ks + 8 * hi);
            f32x16 s[5];
#pragma unroll
            for (int t = 0; t < 5; ++t) { s[t] = zero16;
#pragma unroll
                for (int ks = 0; ks < 4; ++ks) { const bf16x8 kop = *(const LAS bf16x8*)(Ksm + (32 * (kt0 + t) + prow) * KS + (16 * ks + 8 * hi) * 2); s[t] = __builtin_amdgcn_mfma_f32_32x32x16_bf16(kop, qop[ks], s[t], 0, 0, 0); } }
            float m = sink2;
#pragma unroll
            for (int t = 0; t < 5; ++t)
#pragma unroll
                for (int r = 0; r < 16; ++r) { const int jj = 32 * (kt0 + t) + 16 * hi + r; const bool ok = (jj > qi) && (jj <= qi + 128) && (nb > 0 || jj >= 128);
                    s[t][r] = ok ? s[t][r] : -INFINITY; m = fmaxf(m, s[t][r]); }
            m = fmaxf(m, __shfl_xor(m, 32));
            float l = 0.f;
#pragma unroll
            for (int t = 0; t < 5; ++t)
#pragma unroll
                for (int r = 0; r < 16; ++r) { const float p = __builtin_amdgcn_exp2f(s[t][r] - m); s[t][r] = p; l += p; }
            l += __shfl_xor(l, 32); l += __builtin_amdgcn_exp2f(sink2 - m);
            f32x16 o[2]; o[0] = zero16; o[1] = zero16;
#pragma unroll
            for (int t = 0; t < 5; ++t)
#pragma unroll
                for (int hf = 0; hf < 2; ++hf) {
                    v4u pw; pw.x = pg8::cvt_pk_bf16(s[t][8 * hf + 0], s[t][8 * hf + 1]); pw.y = pg8::cvt_pk_bf16(s[t][8 * hf + 2], s[t][8 * hf + 3]); pw.z = pg8::cvt_pk_bf16(s[t][8 * hf + 4], s[t][8 * hf + 5]); pw.w = pg8::cvt_pk_bf16(s[t][8 * hf + 6], s[t][8 * hf + 7]);
                    const bf16x8 pop = __builtin_bit_cast(bf16x8, pw);
#pragma unroll
                    for (int dt = 0; dt < 2; ++dt) { const bf16x8 vop = *(const LAS bf16x8*)(Vsm + (32 * dt + j) * VS + (32 * (kt0 + t) + 16 * hi + 8 * hf) * 2); o[dt] = __builtin_amdgcn_mfma_f32_32x32x16_bf16(vop, pop, o[dt], 0, 0, 0); }
                }
            const float inv = 1.0f / l;
#pragma unroll
            for (int dt = 0; dt < 2; ++dt)
#pragma unroll
                for (int a4 = 0; a4 < 4; ++a4) { v2u w; w.x = pg8::cvt_pk_bf16(o[dt][4 * a4] * inv, o[dt][4 * a4 + 1] * inv); w.y = pg8::cvt_pk_bf16(o[dt][4 * a4 + 2] * inv, o[dt][4 * a4 + 3] * inv);
                    *(v2u*)(O + qrow * DM + hq * 64 + 32 * dt + 8 * a4 + 4 * hi) = w; }
        }
    }
}

__device__ __forceinline__ void pconv(const float* p, bf16* pb, int G) {
    const int gt = bid_opq() * 512 + tid_opq(), NGT = G * 512;
    for (int i = gt; i < MT * PLE / 4; i += NGT) { const f32x4 v = ((const f32x4*)p)[i]; v2u w; w.x = pg8::cvt_pk_bf16(v[0], v[1]); w.y = pg8::cvt_pk_bf16(v[2], v[3]); ((v2u*)pb)[i] = w; }
}
__device__ __forceinline__ void final_norm(const bf16* hb, float* out, const float* gain, int G) {
    const int tid = tid_opq(), lane = tid & 63, wave = tid >> 6; const int gw = bid_opq() * 8 + wave, NGW = G * 8;
    f32x4 gv[4];
#pragma unroll
    for (int c = 0; c < 2; ++c) { gv[2 * c] = *(const f32x4*)(gain + 8 * lane + 512 * c); gv[2 * c + 1] = *(const f32x4*)(gain + 8 * lane + 512 * c + 4); }
    for (int m = gw; m < MT; m += NGW) { f32x4 v[4]; float s = 0.f;
#pragma unroll
        for (int c = 0; c < 2; ++c) { pg8::unpack8(*(const v4u*)(hb + (size_t)m * DM + 8 * lane + 512 * c), v[2 * c], v[2 * c + 1]); s += pg8::sumsq4(v[2 * c]) + pg8::sumsq4(v[2 * c + 1]); }
        const float rstd = 1.0f / sqrtf(wave_sum(s) * (1.0f / DM) + pg8::RMS_EPS);
#pragma unroll
        for (int c = 0; c < 2; ++c) { float* o = out + (size_t)m * DM + 8 * lane + 512 * c; *(f32x4*)o = v[2 * c] * rstd * gv[2 * c]; *(f32x4*)(o + 4) = v[2 * c + 1] * rstd * gv[2 * c + 1]; } }
}

#define XB_TMO      128
#define XB_XCNT(j)  (256  + 64 * (j))
#define XB_XSUB(j)  (1280 + 64 * (j))
#define XB_XGEN(j)  (2304 + 64 * (j))
#define XB_TOP      3328
#define XB_TOPGEN   3392
#define XCD_BAR_WORDS 3456
#define XB_SPIN_CAP (1u << 18)

__device__ __forceinline__ unsigned xb_ld(unsigned* p)              { return __hip_atomic_load(p, __ATOMIC_RELAXED, __HIP_MEMORY_SCOPE_AGENT); }
__device__ __forceinline__ unsigned xb_add(unsigned* p, unsigned v) { return __hip_atomic_fetch_add(p, v, __ATOMIC_RELAXED, __HIP_MEMORY_SCOPE_AGENT); }
__device__ __forceinline__ unsigned xb_xcc_id() { return (unsigned)__builtin_amdgcn_s_getreg((3 << 11) | 20) & 0xFu; }
#define XB_SPIN(cond, bar) do { unsigned _sp = 0; while (cond) { __builtin_amdgcn_s_sleep(1); \
    if ((++_sp & 255u) == 0u) { if (xb_ld(&(bar)[XB_TMO])) break; if (_sp > XB_SPIN_CAP) { atomicAdd(&(bar)[XB_TMO], 1u); break; } } } } while (0)

struct XcdBarrier {
    unsigned* bar; unsigned x;
    volatile LAS unsigned* st;
};

__device__ __forceinline__ XcdBarrier xcd_barrier_post(unsigned* bar, volatile LAS unsigned* st) {
    XcdBarrier b; b.bar = bar; b.x = xb_xcc_id(); b.st = st;
    if (threadIdx.x == 0) (void)xb_add(&bar[XB_XCNT(b.x)], 1u);
    return b;
}
__device__ __forceinline__ void xcd_barrier_complete(unsigned* bar, unsigned x, unsigned& nloc, unsigned& nx) {
    const unsigned G = gridDim.x * gridDim.y * gridDim.z;
    unsigned sum, cnt, mine, sp = 0u;
    for (;;) {
        sum = 0u; cnt = 0u; mine = 0u;
#pragma unroll
        for (unsigned j = 0; j < 16; ++j) { const unsigned c = xb_ld(&bar[XB_XCNT(j)]); sum += c; cnt += (c > 0u) ? 1u : 0u; mine = (j == x) ? c : mine; }
        if (sum == G) break;
        __builtin_amdgcn_s_sleep(1);
        if ((++sp & 255u) == 0u) { if (xb_ld(&bar[XB_TMO])) break; if (sp > XB_SPIN_CAP) { atomicAdd(&bar[XB_TMO], 1u); break; } }
    }
    nloc = mine > 0u ? mine : 1u; nx = cnt > 0u ? cnt : 1u;
}

__device__ __forceinline__ void xcd_barrier(const XcdBarrier& b) {
    asm volatile("s_waitcnt vmcnt(0)" ::: "memory");
    __syncthreads();
    if (threadIdx.x == 0) {
        unsigned* bar = b.bar;
        __builtin_amdgcn_s_waitcnt(0);
        unsigned nloc = b.st[0], nx = b.st[1];
        if (nloc == 0u) { xcd_barrier_complete(bar, b.x, nloc, nx); b.st[0] = nloc; b.st[1] = nx; }
        const unsigned old = xb_add(&bar[XB_XSUB(b.x)], 1u);
        const unsigned gen = old / nloc;
        if (old + 1u == (gen + 1u) * nloc) {
            __builtin_amdgcn_fence(__ATOMIC_RELEASE, "agent");
            asm volatile("s_waitcnt vmcnt(0)" ::: "memory");
            const unsigned og = xb_add(&bar[XB_TOP], 1u);
            const unsigned tg = og / nx;
            if (og + 1u == (tg + 1u) * nx) xb_add(&bar[XB_TOPGEN], 1u);
            else XB_SPIN(xb_ld(&bar[XB_TOPGEN]) == tg, bar);
            __builtin_amdgcn_fence(__ATOMIC_ACQUIRE, "agent");
            xb_add(&bar[XB_XGEN(b.x)], 1u);
            asm volatile("s_waitcnt vmcnt(0)" ::: "memory");
        } else {
            XB_SPIN(xb_ld(&bar[XB_XGEN(b.x)]) == gen, bar);
            __builtin_amdgcn_fence(__ATOMIC_ACQUIRE, "agent");
            asm volatile("s_waitcnt vmcnt(0)" ::: "memory");
        }
    }
    __syncthreads();
}

__device__ __forceinline__ void xcd_arrive(const XcdBarrier& b) {
    asm volatile("s_waitcnt vmcnt(0)" ::: "memory");
    __syncthreads();
    if (threadIdx.x == 0) {
        unsigned* bar = b.bar;
        __builtin_amdgcn_s_waitcnt(0);
        unsigned nloc = b.st[0], nx = b.st[1];
        if (nloc == 0u) { xcd_barrier_complete(bar, b.x, nloc, nx); b.st[0] = nloc; b.st[1] = nx; }
        const unsigned old = xb_add(&bar[XB_XSUB(b.x)], 1u);
        const unsigned gen = old / nloc;
        if (old + 1u == (gen + 1u) * nloc) {
            __builtin_amdgcn_fence(__ATOMIC_RELEASE, "agent");
            asm volatile("s_waitcnt vmcnt(0)" ::: "memory");
            const unsigned og = xb_add(&bar[XB_TOP], 1u);
            const unsigned tg = og / nx;
            if (og + 1u == (tg + 1u) * nx) xb_add(&bar[XB_TOPGEN], 1u);
            else XB_SPIN(xb_ld(&bar[XB_TOPGEN]) == tg, bar);
            __builtin_amdgcn_fence(__ATOMIC_ACQUIRE, "agent");
            xb_add(&bar[XB_XGEN(b.x)], 1u);
            asm volatile("s_waitcnt vmcnt(0)" ::: "memory");
        }
        b.st[3] = gen;
    }
}
__device__ __forceinline__ void xcd_wait(const XcdBarrier& b) {
    asm volatile("s_waitcnt vmcnt(0)" ::: "memory");
    __syncthreads();
    if (threadIdx.x == 0) {
        unsigned* bar = b.bar; const unsigned gen = b.st[3];
        XB_SPIN(xb_ld(&bar[XB_XGEN(b.x)]) == gen, bar);
        __builtin_amdgcn_fence(__ATOMIC_ACQUIRE, "agent");
        asm volatile("s_waitcnt vmcnt(0)" ::: "memory");
    }
    __syncthreads();
}

__global__ void __launch_bounds__(512, 2) yoco_fwd(Args a_bytes) {
    extern __shared__ __attribute__((aligned(16))) unsigned char lds_raw[];
    LAS unsigned char* lds = (LAS unsigned char*)lds_raw;
    cg::grid_group grid = cg::this_grid();
    int ph = 0, lo, hi;
    { kap_t ap = kargs(); lo = ap->ph_lo; hi = ap->ph_hi; }
    volatile LAS unsigned* bst = (volatile LAS unsigned*)(lds + 131072 + 64);
    if (threadIdx.x < 4) bst[threadIdx.x] = 0u;
    __syncthreads();
    XcdBarrier xbar; { kap_t ap = kargs(); xbar = xcd_barrier_post((unsigned*)((unsigned char*)ap->ws + WS_CTL), bst); }
#ifndef PROBE_DUP
#define PROBE_DUP 0ull
#endif
#if PROBE_DUP
#define RUN() for (int rep_ = 0, nrep_ = (lo <= ph && ph < hi) ? 1 + (int)((PROBE_DUP >> ph) & 1ull) : 0; rep_ < nrep_; ++rep_) if (rep_ == 0 || (grid.sync(), true))
#else
#define RUN() (lo <= ph && ph < hi)
#endif
#if PROBE_DUP
#define IFRUN RUN()
#else
#define IFRUN if (RUN())
#endif
#define SEAM() do { if (lo <= ph && ph + 1 < hi) { if (ph == 0) grid.sync(); else xcd_barrier(xbar); } ++ph; } while (0)
#define SEAM_WITH(work) do { const bool split_ = (lo <= ph && ph + 1 < hi); if (split_) xcd_arrive(xbar); IFRUN { PHASE_VARS; work; } if (split_) xcd_wait(xbar); ++ph; } while (0)
#define PHASE_VARS kap_t ap = kargs(); const int G = ap->grid; unsigned char* ws = (unsigned char*)ap->ws; \
    float* ssb = (float*)(ws + WS_SS); float* ss_in = ssb + (size_t)((3 * layer) & 3) * MT * 32; float* ss_mix = ssb + (size_t)((3 * layer + 1) & 3) * MT * 32; float* ss_mlp = ssb + (size_t)((3 * layer + 2) & 3) * MT * 32; float* ss_ple = ssb + (size_t)((3 * layer + 3) & 3) * MT * 32; (void)ss_mix; (void)ss_mlp; (void)ss_ple; \
    const bf16* hin = (const bf16*)(ws + WS_ACT + ACT_HB2); (void)hin;
    IFRUN { kap_t ap = kargs(); phase0(ap, lds, ap->grid); }
    SEAM();
#pragma unroll 1
    for (int layer = 0; layer < 4; ++layer) {
        if (layer < 2) {
            IFRUN { PHASE_VARS; s5_pass<false>(lds, G, hin, ss_in, ws + WS_S5T + (size_t)layer * MiB, KIN(2) + layer * DM, KIN(10) + layer * DM, (float*)(ws + WS_ACT + ACT_ST), (bf16*)(ws + WS_ACT + ACT_Y)); }
            SEAM();
            IFRUN { PHASE_VARS; s5_carry(G, ws + WS_S5T + (size_t)layer * MiB, (float*)(ws + WS_ACT + ACT_ST)); }
            SEAM();
            IFRUN { PHASE_VARS; s5_pass<true>(lds, G, hin, ss_in, ws + WS_S5T + (size_t)layer * MiB, KIN(2) + layer * DM, KIN(10) + layer * DM, (float*)(ws + WS_ACT + ACT_ST), (bf16*)(ws + WS_ACT + ACT_Y)); }
            SEAM();
            IFRUN { PHASE_VARS;
                pg8::Gemm g{(const bf16*)(ws + WS_ACT + ACT_Y), (const bf16*)(ws + WS_WGLU) + (size_t)layer * 2048 * DM, MT, 2048, DM}; pg8::StaticOrder S; S.init(MT, 2048, G, bid_opq());
                pg8::EpiGlu E{hin, (bf16*)(ws + WS_HB), ss_mix};
                pg8::gemm_phase<pg8::EpiGlu, pg8::StaticOrder, true, true>(lds, g, S, E); }
            SEAM_WITH(pconv(KIN(1) + (size_t)layer * MT * PLE, (bf16*)(ws + WS_PB), G));
        } else {
            IFRUN { PHASE_VARS; const int j = layer - 2; const int N = j == 0 ? 1536 : 1024;
                pg8::Gemm g{(const bf16*)(ws + WS_ACT + ACT_HB2), (const bf16*)(ws + (j == 0 ? WS_WQKV2 : WS_WQ3)), MT, N, DM}; pg8::StaticOrder S; S.init(MT, N, G, bid_opq());
                pg8::EpiQKV E{(bf16*)(ws + WS_ACT + ACT_Q), (bf16*)(ws + WS_K), (bf16*)(ws + WS_VT), ss_in, (const float*)(ws + WS_ROPE), (const float*)(ws + WS_ROPE) + SEQ * 8};
                pg8::gemm_phase<pg8::EpiQKV, pg8::StaticOrder, true, true>(lds, g, S, E); }
            SEAM();
            IFRUN { PHASE_VARS; attn_phase(lds, G, (const bf16*)(ws + WS_ACT + ACT_Q), (const bf16*)(ws + WS_K), (const bf16*)(ws + WS_VT), (bf16*)(ws + WS_ACT + ACT_O), KIN(16) + (layer - 2) * 16); }
            SEAM();
            IFRUN { PHASE_VARS;
                pg8::Gemm g{(const bf16*)(ws + WS_ACT + ACT_O), (const bf16*)(ws + WS_WO) + (size_t)(layer - 2) * DM * DM, MT, DM, DM}; pg8::StaticOrder S; S.init(MT, DM, G, bid_opq());
                pg8::EpiRes<0> E{hin, (bf16*)(ws + WS_HB), ss_mix, nullptr};
                pg8::gemm_phase<pg8::EpiRes<0>, pg8::StaticOrder, true, true>(lds, g, S, E); }
            SEAM_WITH(pconv(KIN(1) + (size_t)layer * MT * PLE, (bf16*)(ws + WS_PB), G));
        }
        IFRUN { PHASE_VARS; pg8::Gemm g{(const bf16*)(ws + WS_HB), (const bf16*)(ws + WS_WUP) + (size_t)layer * FF * DM, MT, FF, DM}; pg8::StaticOrder S; S.init(MT, FF, G, bid_opq());
            pg8::EpiUp E{(bf16*)(ws + WS_ACT)}; pg8::gemm_phase<pg8::EpiUp, pg8::StaticOrder, true, true>(lds, g, S, E); }
        SEAM();
        IFRUN { PHASE_VARS; pg8::Gemm g{(const bf16*)(ws + WS_ACT), (const bf16*)(ws + WS_WDOWN) + (size_t)layer * DM * FF, MT, DM, FF}; pg8::StaticOrder S; S.init(MT, DM, G, bid_opq());
            if (layer < 2) { pg8::EpiRes<8> E{(const bf16*)(ws + WS_HB), (bf16*)(ws + WS_HB), ss_mlp, ss_mix}; pg8::gemm_phase<pg8::EpiRes<8>, pg8::StaticOrder, true, true, true>(lds, g, S, E); }
            else { pg8::EpiRes<4> E{(const bf16*)(ws + WS_HB), (bf16*)(ws + WS_HB), ss_mlp, ss_mix}; pg8::gemm_phase<pg8::EpiRes<4>, pg8::StaticOrder, true, true, true>(lds, g, S, E); } }
        { const bool split = (lo <= ph && ph + 1 < hi);
          if (split) xcd_arrive(xbar);
          IFRUN { PHASE_VARS; pg8::Gemm g{(const bf16*)(ws + WS_PB), (const bf16*)(ws + WS_WPROJ) + (size_t)layer * DM * PLE, MT, DM, PLE}; pg8::StaticOrder S; S.init(MT, DM, G, bid_opq());
              pg8::EpiPP E{(bf16*)(float*)ap->out};
              pg8::gemm_phase<pg8::EpiPP, pg8::StaticOrder, true, true>(lds, g, S, E); }
          if (split) xcd_wait(xbar);
          ++ph; }
        IFRUN { PHASE_VARS; pg8::Gemm g{(const bf16*)(ws + WS_HB), (const bf16*)(ws + WS_WGATE) + (size_t)layer * DM * DM, MT, DM, DM}; pg8::StaticOrder S; S.init(MT, DM, G, bid_opq());
            pg8::EpiGate E{(const bf16*)(ws + WS_HB), (bf16*)(ws + WS_ACT + ACT_HB2), ss_ple, ss_mlp, (const bf16*)(float*)ap->out};
            pg8::gemm_phase<pg8::EpiGate, pg8::StaticOrder, true, true>(lds, g, S, E); }
        SEAM();
    }
    IFRUN { kap_t ap = kargs(); final_norm((const bf16*)((unsigned char*)ap->ws + WS_ACT + ACT_HB2), (float*)ap->out, KIN(24), ap->grid); }
#undef RUN
#undef SEAM
#undef PHASE_VARS
}

extern "C" void kernel_launch(void* const* d_in, const int* in_sizes, int n_in, void* d_out, int out_size, void* d_ws, size_t ws_size, hipStream_t stream) {
    static int grid = 0;
    if (grid == 0) {
        if (n_in != 25 || in_sizes[0] != MT * DM || out_size != MT * DM || ws_size < WS_END) { fprintf(stderr, "kernel_launch: unexpected shapes (n_in %d, in0 %d, out %d, ws %zu); nothing launched\n", n_in, n_in > 0 ? in_sizes[0] : -1, out_size, ws_size); grid = -1; return; }
        int dev = 0, cus = 0, per_cu = 0;
        if (hipGetDevice(&dev) != hipSuccess || hipDeviceGetAttribute(&cus, hipDeviceAttributeMultiprocessorCount, dev) != hipSuccess) { grid = -1; return; }
        if (hipFuncSetAttribute((const void*)yoco_fwd, hipFuncAttributeMaxDynamicSharedMemorySize, LDS_BYTES) != hipSuccess) { fprintf(stderr, "kernel_launch: hipFuncSetAttribute failed\n"); grid = -1; return; }
        if (hipOccupancyMaxActiveBlocksPerMultiprocessor(&per_cu, (const void*)yoco_fwd, 512, LDS_BYTES) != hipSuccess || per_cu < 1) { fprintf(stderr, "kernel_launch: occupancy query reports %d workgroups per CU\n", per_cu); per_cu = 1; }
        (void)hipGetLastError();
        grid = cus;
    }
    if (grid < 0) return;
    Args a{};
    for (int i = 0; i < 25; ++i) a.in[i] = (const float*)d_in[i];
    a.out = (float*)d_out; a.ws = (unsigned char*)d_ws;
    for (int i = 0; i < 8; ++i) a.inv[i] = pow(500000.0, -(double)(2 * i) / 16.0);
#if MK_SINGLE
    if (hipMemsetAsync((char*)d_ws + WS_CTL, 0, 16384, stream) != hipSuccess) { fprintf(stderr, "kernel_launch: hipMemsetAsync failed\n"); return; }
    a.ph_lo = 0; a.ph_hi = NPHASE; a.grid = grid;
    void* args[] = {&a};
    hipError_t e = hipLaunchCooperativeKernel((const void*)yoco_fwd, dim3(grid), dim3(512), args, LDS_BYTES, stream);
    if (e != hipSuccess) fprintf(stderr, "kernel_launch: cooperative launch failed: %s (grid %d)\n", hipGetErrorString(e), grid);
#else
    a.grid = grid; for (int p = 0; p < NPHASE; ++p) { a.ph_lo = p; a.ph_hi = p + 1; hipLaunchKernelGGL(yoco_fwd, dim3(grid), dim3(512), LDS_BYTES, stream, a); }
#endif
}
```
